# Optimizing an MI355X kernel written in HIP

```python
import math
import jax
import jax.numpy as jnp
from jax import lax
import numpy as np

D_MODEL = 1024
BATCH = 4
SEQ = 4096
DEPTH = 1

CHUNK = 64
Q_BLOCK = 128
ROPE_THETA = 500000.0
EPS = 1e-6

MLA_HEADS = 8
MLA_NOPE = 64
MLA_ROPE = 32
MLA_V = 64
MLA_QK = MLA_NOPE + MLA_ROPE
MLA_Q_RANK = 256
MLA_KV_RANK = 128
MLA_V_WIDTH = MLA_HEADS * MLA_V

DIFF_HEADS = 4
DIFF_HEAD_DIM = 64
DIFF_V_DIM = 2 * DIFF_HEAD_DIM
DIFF_ROPE = DIFF_HEAD_DIM // 4
DIFF_QK_WIDTH = DIFF_HEADS * 2 * DIFF_HEAD_DIM
DIFF_V_WIDTH = DIFF_HEADS * DIFF_V_DIM

N_GROUPS = 4
EXPERTS_PER_GROUP = 8
N_EXPERTS = N_GROUPS * EXPERTS_PER_GROUP
TOP_K = 2
EXPERT_FF = 256

IN_SIZES = (MLA_Q_RANK, MLA_KV_RANK, MLA_ROPE, DIFF_QK_WIDTH, DIFF_QK_WIDTH, DIFF_V_WIDTH, D_MODEL, D_MODEL)
IN_WIDTH = sum(IN_SIZES)
IN_SPLITS = tuple(int(s) for s in np.cumsum(IN_SIZES)[:-1])

kernel_name = 'hybrid_mla_diffattn_hiermoe_block'


def rms_norm(x, gain):
    x32 = x.astype(jnp.float32)
    y = x32 * lax.rsqrt(jnp.mean(x32 * x32, axis=-1, keepdims=True) + EPS)
    return (y * gain.astype(jnp.float32)).astype(x.dtype)


def rope_tables(seq_len, rot_dim):
    pos = jnp.arange(seq_len, dtype=jnp.float32)
    inv = 1.0 / (ROPE_THETA ** (jnp.arange(0, rot_dim, 2, dtype=jnp.float32) / rot_dim))
    ang = pos[:, None] * inv[None, :]
    return jnp.cos(ang), jnp.sin(ang)


def apply_rope(x, cos, sin):
    shape = (1, cos.shape[0]) + (1,) * (x.ndim - 3) + (cos.shape[1],)
    c = cos.reshape(shape)
    s = sin.reshape(shape)
    x32 = x.astype(jnp.float32)
    x1, x2 = jnp.split(x32, 2, axis=-1)
    return jnp.concatenate([x1 * c - x2 * s, x2 * c + x1 * s], axis=-1).astype(x.dtype)


def chunk_causal_probs(q_blk, k_ctx, q_start, scale):
    n_q = q_blk.shape[1]
    n_k = k_ctx.shape[1]
    s = jnp.einsum('bqhd,bkhd->bhqk', q_blk.astype(jnp.float32), k_ctx.astype(jnp.float32)) * scale
    q_chunk = (q_start + jnp.arange(n_q)) // CHUNK
    k_chunk = jnp.arange(n_k) // CHUNK
    s = jnp.where(k_chunk[None, :] <= q_chunk[:, None], s, -jnp.inf)
    return jax.nn.softmax(s, axis=-1)


def mla_branch(q_lat, kv_lat, k_rope_in, q_lat_norm, w_uq, kv_lat_norm, w_ukv, q_gain, k_gain, cos, sin):
    b, s, _ = q_lat.shape
    q = (rms_norm(q_lat, q_lat_norm) @ w_uq).reshape(b, s, MLA_HEADS, MLA_QK)
    kv = (rms_norm(kv_lat, kv_lat_norm) @ w_ukv).reshape(b, s, MLA_HEADS, MLA_NOPE + MLA_V)
    k_nope, v = kv[..., :MLA_NOPE], kv[..., MLA_NOPE:]
    k_rope = jnp.broadcast_to(k_rope_in[:, :, None, :], (b, s, MLA_HEADS, MLA_ROPE))
    k = jnp.concatenate([k_nope, k_rope], axis=-1)
    q = rms_norm(q, q_gain)
    k = rms_norm(k, k_gain)
    q = jnp.concatenate([q[..., :MLA_NOPE], apply_rope(q[..., MLA_NOPE:], cos, sin)], axis=-1)
    k = jnp.concatenate([k[..., :MLA_NOPE], apply_rope(k[..., MLA_NOPE:], cos, sin)], axis=-1)
    scale = MLA_QK ** -0.5
    outs = []
    for start in range(0, s, Q_BLOCK):
        end = start + Q_BLOCK
        p = chunk_causal_probs(q[:, start:end], k[:, :end], start, scale)
        outs.append(jnp.einsum('bhqk,bkhd->bqhd', p, v[:, :end].astype(jnp.float32)))
    o = jnp.concatenate(outs, axis=1).astype(q_lat.dtype)
    return o.reshape(b, s, MLA_V_WIDTH)


def diff_branch(q_in, k_in, v_in, q_gain, k_gain, lq1, lk1, lq2, lk2, subln, lambda_init, cos, sin):
    b, s, _ = q_in.shape
    q = rms_norm(q_in.reshape(b, s, DIFF_HEADS, 2, DIFF_HEAD_DIM), q_gain)
    k = rms_norm(k_in.reshape(b, s, DIFF_HEADS, 2, DIFF_HEAD_DIM), k_gain)
    v = v_in.reshape(b, s, DIFF_HEADS, DIFF_V_DIM)
    q = jnp.concatenate([apply_rope(q[..., :DIFF_ROPE], cos, sin), q[..., DIFF_ROPE:]], axis=-1)
    k = jnp.concatenate([apply_rope(k[..., :DIFF_ROPE], cos, sin), k[..., DIFF_ROPE:]], axis=-1)
    q1, q2 = q[:, :, :, 0], q[:, :, :, 1]
    k1, k2 = k[:, :, :, 0], k[:, :, :, 1]
    lam = (jnp.exp(jnp.sum(lq1.astype(jnp.float32) * lk1.astype(jnp.float32)))
           - jnp.exp(jnp.sum(lq2.astype(jnp.float32) * lk2.astype(jnp.float32))) + lambda_init)
    scale = DIFF_HEAD_DIM ** -0.5
    outs = []
    for start in range(0, s, Q_BLOCK):
        end = start + Q_BLOCK
        p1 = chunk_causal_probs(q1[:, start:end], k1[:, :end], start, scale)
        p2 = chunk_causal_probs(q2[:, start:end], k2[:, :end], start, scale)
        a = p1 - lam * p2
        outs.append(jnp.einsum('bhqk,bkhd->bqhd', a, v[:, :end].astype(jnp.float32)))
    o = jnp.concatenate(outs, axis=1)
    o = rms_norm(o, subln) * (1.0 - lambda_init)
    return o.astype(q_in.dtype).reshape(b, s, DIFF_V_WIDTH)


def hier_moe(h, w_rg, b_rg, w_re, b_re, w_gate, w_up, w_down):
    b, s, d = h.shape
    t = h.reshape(b * s, d)
    n = t.shape[0]
    group_logits = (t @ w_rg).astype(jnp.float32) + b_rg.astype(jnp.float32)
    p_group = jax.nn.softmax(group_logits, axis=-1)
    pg_sel, g_idx = lax.top_k(p_group, 1)
    exp_logits = ((t @ w_re).astype(jnp.float32) + b_re.astype(jnp.float32)).reshape(n, N_GROUPS, EXPERTS_PER_GROUP)
    in_group = jnp.take_along_axis(exp_logits, g_idx[:, :, None], axis=1)[:, 0]
    p_exp = jax.nn.softmax(in_group, axis=-1)
    pe_top, e_idx = lax.top_k(p_exp, TOP_K)
    weights = pg_sel * pe_top / jnp.sum(pe_top, axis=-1, keepdims=True)
    global_idx = g_idx * EXPERTS_PER_GROUP + e_idx
    combine = jnp.sum(jax.nn.one_hot(global_idx, N_EXPERTS, dtype=jnp.float32) * weights[..., None], axis=1)
    out = jnp.zeros((n, d), jnp.float32)
    for e in range(N_EXPERTS):
        hidden = jax.nn.silu(t @ w_gate[e]) * (t @ w_up[e])
        out = out + combine[:, e:e + 1] * (hidden @ w_down[e]).astype(jnp.float32)
    return out.astype(h.dtype).reshape(b, s, d)


def setup_inputs(seed: int = 0) -> dict:
    key = jax.random.key(seed)
    ks = jax.random.split(key, 32)
    f32 = jnp.float32
    L = DEPTH

    def w(k, shape, fan_in):
        return jax.random.normal(k, shape, f32) * (fan_in ** -0.5)

    def gain(k, shape):
        return 1.0 + 0.02 * jax.random.normal(k, shape, f32)

    def small(k, shape, sc):
        return sc * jax.random.normal(k, shape, f32)

    return {
        'x': jax.random.normal(ks[0], (BATCH, SEQ, D_MODEL), f32),
        'norm_mix': gain(ks[1], (L, D_MODEL)),
        'w_in': w(ks[2], (L, D_MODEL, IN_WIDTH), D_MODEL),
        'mla_q_latent_norm': gain(ks[3], (L, MLA_Q_RANK)),
        'w_mla_uq': w(ks[4], (L, MLA_Q_RANK, MLA_HEADS * MLA_QK), MLA_Q_RANK),
        'mla_kv_latent_norm': gain(ks[5], (L, MLA_KV_RANK)),
        'w_mla_ukv': w(ks[6], (L, MLA_KV_RANK, MLA_HEADS * (MLA_NOPE + MLA_V)), MLA_KV_RANK),
        'mla_q_gain': gain(ks[7], (L, MLA_QK)),
        'mla_k_gain': gain(ks[8], (L, MLA_QK)),
        'diff_q_gain': gain(ks[9], (L, DIFF_HEAD_DIM)),
        'diff_k_gain': gain(ks[10], (L, DIFF_HEAD_DIM)),
        'lambda_q1': small(ks[11], (L, DIFF_HEAD_DIM), 0.1),
        'lambda_k1': small(ks[12], (L, DIFF_HEAD_DIM), 0.1),
        'lambda_q2': small(ks[13], (L, DIFF_HEAD_DIM), 0.1),
        'lambda_k2': small(ks[14], (L, DIFF_HEAD_DIM), 0.1),
        'diff_subln': gain(ks[15], (L, DIFF_V_DIM)),
        'w_mla_up': w(ks[16], (L, MLA_V_WIDTH, D_MODEL), MLA_V_WIDTH),
        'w_diff_up': w(ks[17], (L, DIFF_V_WIDTH, D_MODEL), DIFF_V_WIDTH),
        'w_out': w(ks[18], (L, D_MODEL, D_MODEL), D_MODEL),
        'norm_ffn': gain(ks[19], (L, D_MODEL)),
        'w_router_group': w(ks[20], (L, D_MODEL, N_GROUPS), D_MODEL),
        'b_router_group': small(ks[21], (L, N_GROUPS), 0.01),
        'w_router_expert': w(ks[22], (L, D_MODEL, N_EXPERTS), D_MODEL),
        'b_router_expert': small(ks[23], (L, N_EXPERTS), 0.01),
        'w_expert_gate': w(ks[24], (L, N_EXPERTS, D_MODEL, EXPERT_FF), D_MODEL),
        'w_expert_up': w(ks[25], (L, N_EXPERTS, D_MODEL, EXPERT_FF), D_MODEL),
        'w_expert_down': w(ks[26], (L, N_EXPERTS, EXPERT_FF, D_MODEL), EXPERT_FF),
    }


def reference(x, norm_mix, w_in, mla_q_latent_norm, w_mla_uq, mla_kv_latent_norm, w_mla_ukv,
              mla_q_gain, mla_k_gain, diff_q_gain, diff_k_gain, lambda_q1, lambda_k1, lambda_q2, lambda_k2,
              diff_subln, w_mla_up, w_diff_up, w_out, norm_ffn, w_router_group, b_router_group,
              w_router_expert, b_router_expert, w_expert_gate, w_expert_up, w_expert_down):
    seq_len = x.shape[1]
    cos_mla, sin_mla = rope_tables(seq_len, MLA_ROPE)
    cos_diff, sin_diff = rope_tables(seq_len, DIFF_ROPE)
    for l in range(DEPTH):
        lambda_init = 0.8 - 0.6 * math.exp(-0.3 * l)
        h = rms_norm(x, norm_mix[l])
        proj = h @ w_in[l]
        q_lat, kv_lat, k_rope_in, dq, dk, dv, g_mla, g_diff = jnp.split(proj, IN_SPLITS, axis=-1)
        o_mla = mla_branch(q_lat, kv_lat, k_rope_in, mla_q_latent_norm[l], w_mla_uq[l],
                           mla_kv_latent_norm[l], w_mla_ukv[l], mla_q_gain[l], mla_k_gain[l],
                           cos_mla, sin_mla)
        o_diff = diff_branch(dq, dk, dv, diff_q_gain[l], diff_k_gain[l], lambda_q1[l], lambda_k1[l],
                             lambda_q2[l], lambda_k2[l], diff_subln[l], lambda_init, cos_diff, sin_diff)
        merged = (jax.nn.sigmoid(g_mla) * (o_mla @ w_mla_up[l])
                  + jax.nn.sigmoid(g_diff) * (o_diff @ w_diff_up[l]))
        x = x + merged @ w_out[l]
        h2 = rms_norm(x, norm_ffn[l])
        x = x + hier_moe(h2, w_router_group[l], b_router_group[l], w_router_expert[l], b_router_expert[l],
                         w_expert_gate[l], w_expert_up[l], w_expert_down[l])
    return x
```

```cpp
#include <hip/hip_runtime.h>
#include <cstdio>
#include <cstdint>

#ifndef MK_N_LAUNCHES
#define MK_N_LAUNCHES 1
#endif

constexpr int BATCH = 4, SEQ = 4096, DM = 1024, NTOK = BATCH * SEQ;
constexpr int INW = 4000;
constexpr float EPS = 1e-6f;
constexpr float LOG2E = 1.4426950408889634f;
constexpr float QS_MLA = 0.10206207261596577f * LOG2E;
constexpr float QS_DIFF = 0.125f * LOG2E;
constexpr float LAMBDA_INIT = 0.2f;
constexpr int NEXP = 32;

constexpr size_t MiB = 1u << 20;
constexpr size_t WS_CTL = 0, CTL_ZERO_BYTES = 1 * MiB;
constexpr size_t WS_TAB = 14 * MiB;
constexpr size_t WS_XN = 16 * MiB;
constexpr size_t WS_QM = 16 * MiB;
constexpr size_t WS_LAT = 48 * MiB;
constexpr size_t WS_DKR = 64 * MiB;
constexpr size_t WS_DQ = 80 * MiB;
constexpr size_t WS_DV = 96 * MiB;
constexpr size_t WS_GM = 112 * MiB;
constexpr size_t WS_GD = 144 * MiB;
constexpr size_t WS_KM = 176 * MiB;
constexpr size_t WS_VM = 200 * MiB;
constexpr size_t WS_KD = 216 * MiB;
constexpr size_t WS_OM = 232 * MiB;
constexpr size_t WS_OD = 48 * MiB;
constexpr size_t WS_ODN = 176 * MiB;
constexpr size_t WS_MG = 192 * MiB;
constexpr size_t WS_H2N = 176 * MiB;
constexpr size_t WS_Y = 112 * MiB;
constexpr size_t WS_END = 256 * MiB;

constexpr size_t TB_COSM = 0, TB_SINM = 256 * 1024, TB_COSD = 512 * 1024, TB_SIND = 640 * 1024, TB_LAM = 768 * 1024;
constexpr size_t TB_TOKE = 832 * 1024;
constexpr size_t TB_TOKW = 960 * 1024;

constexpr int CW_BAR = 4096;
constexpr int CW_CNT = 1024;

constexpr int LDS_BYTES = 147456;
constexpr int RING_BYTES = 131072;
constexpr int LDSCTL_OFF = RING_BYTES, MISC_OFF = LDSCTL_OFF + 320;
constexpr int NWAVES = 8;

#define GAS __attribute__((address_space(1)))
#define LAS __attribute__((address_space(3)))
typedef unsigned short bf16;
typedef unsigned v4u __attribute__((ext_vector_type(4)));
typedef unsigned v2u __attribute__((ext_vector_type(2)));
typedef float f32x4 __attribute__((ext_vector_type(4)));
typedef GAS unsigned gu32;

__device__ __forceinline__ unsigned f2bf(float f) { unsigned u = __builtin_bit_cast(unsigned, f); return (u + 0x7fffu + ((u >> 16) & 1u)) >> 16; }
__device__ __forceinline__ float bf2f(unsigned b) { return __builtin_bit_cast(float, (b & 0xffffu) << 16); }
__device__ __forceinline__ float bfr(float f) { return bf2f(f2bf(f)); }
__device__ __forceinline__ unsigned pk2(float lo, float hi) { return f2bf(lo) | (f2bf(hi) << 16); }
__device__ __forceinline__ float wave_sum(float v) {
#pragma unroll
    for (int o = 1; o < 64; o <<= 1) v += __shfl_xor(v, o);
    return v;
}
__device__ __forceinline__ float wave_max(float v) {
#pragma unroll
    for (int o = 1; o < 64; o <<= 1) v = fmaxf(v, __shfl_xor(v, o));
    return v;
}

#define XB_TMO      128
#define XB_XCNT(j)  (256  + 64 * (j))
#define XB_XSUB(j)  (1280 + 64 * (j))
#define XB_XGEN(j)  (2304 + 64 * (j))
#define XB_TOP      3328
#define XB_TOPGEN   3392
#define XCD_BAR_WORDS 3456
#define XB_SPIN_CAP (1u << 22)
__device__ __forceinline__ unsigned xb_ld(unsigned* p)              { return __hip_atomic_load(p, __ATOMIC_RELAXED, __HIP_MEMORY_SCOPE_AGENT); }
__device__ __forceinline__ unsigned xb_add(unsigned* p, unsigned v) { return __hip_atomic_fetch_add(p, v, __ATOMIC_RELAXED, __HIP_MEMORY_SCOPE_AGENT); }
__device__ __forceinline__ unsigned xb_xcc_id() { return (unsigned)__builtin_amdgcn_s_getreg((3 << 11) | 20) & 0xFu; }
#define XB_SPIN(cond, bar) do { unsigned _sp = 0; while (cond) { __builtin_amdgcn_s_sleep(1); \
    if ((++_sp & 255u) == 0u) { if (xb_ld(&(bar)[XB_TMO])) break; if (_sp > XB_SPIN_CAP) { atomicAdd(&(bar)[XB_TMO], 1u); break; } } } } while (0)
struct XcdBarrier { unsigned* bar; unsigned x; volatile LAS unsigned* st; };
__device__ __forceinline__ XcdBarrier xcd_barrier_post(unsigned* bar, volatile LAS unsigned* st) {
    XcdBarrier b; b.bar = bar; b.x = xb_xcc_id(); b.st = st;
    if (threadIdx.x == 0) (void)xb_add(&bar[XB_XCNT(b.x)], 1u);
    return b;
}
__device__ __forceinline__ void xcd_barrier_complete(unsigned* bar, unsigned x, unsigned& nloc, unsigned& nx) {
    const unsigned G = gridDim.x * gridDim.y * gridDim.z;
    unsigned sum, cnt, mine, sp = 0u;
    for (;;) {
        sum = 0u; cnt = 0u; mine = 0u;
#pragma unroll
        for (unsigned j = 0; j < 16; ++j) { const unsigned c = xb_ld(&bar[XB_XCNT(j)]); sum += c; cnt += (c > 0u) ? 1u : 0u; mine = (j == x) ? c : mine; }
        if (sum == G) break;
        __builtin_amdgcn_s_sleep(1);
        if ((++sp & 255u) == 0u) { if (xb_ld(&bar[XB_TMO])) break; if (sp > XB_SPIN_CAP) { atomicAdd(&bar[XB_TMO], 1u); break; } }
    }
    nloc = mine > 0u ? mine : 1u; nx = cnt > 0u ? cnt : 1u;
}
__device__ __forceinline__ void xcd_barrier(const XcdBarrier& b) {
    asm volatile("s_waitcnt vmcnt(0)" ::: "memory");
    __syncthreads();
    if (threadIdx.x == 0) {
        unsigned* bar = b.bar;
        __builtin_amdgcn_s_waitcnt(0);
        unsigned nloc = b.st[0], nx = b.st[1];
        if (nloc == 0u) { xcd_barrier_complete(bar, b.x, nloc, nx); b.st[0] = nloc; b.st[1] = nx; }
        const unsigned old = xb_add(&bar[XB_XSUB(b.x)], 1u);
        const unsigned gen = old / nloc;
        if (old + 1u == (gen + 1u) * nloc) {
            __builtin_amdgcn_fence(__ATOMIC_RELEASE, "agent");
            asm volatile("s_waitcnt vmcnt(0)" ::: "memory");
            const unsigned og = xb_add(&bar[XB_TOP], 1u);
            const unsigned tg = og / nx;
            if (og + 1u == (tg + 1u) * nx) xb_add(&bar[XB_TOPGEN], 1u);
            else XB_SPIN(xb_ld(&bar[XB_TOPGEN]) == tg, bar);
            __builtin_amdgcn_fence(__ATOMIC_ACQUIRE, "agent");
            xb_add(&bar[XB_XGEN(b.x)], 1u);
            asm volatile("s_waitcnt vmcnt(0)" ::: "memory");
        } else {
            XB_SPIN(xb_ld(&bar[XB_XGEN(b.x)]) == gen, bar);
            __builtin_amdgcn_fence(__ATOMIC_ACQUIRE, "agent");
            asm volatile("s_waitcnt vmcnt(0)" ::: "memory");
        }
    }
    __syncthreads();
}

struct Args { const float* in[27]; float* out; unsigned char* ws; int ph_lo, ph_hi, li, pad; };
enum { I_X = 0, I_NMIX, I_WIN, I_QLN, I_WUQ, I_KVLN, I_WUKV, I_QG, I_KG, I_DQG, I_DKG, I_LQ1, I_LK1, I_LQ2, I_LK2, I_SUBLN,
       I_WMU, I_WDU, I_WOUT, I_NFFN, I_WRG, I_BRG, I_WRE, I_BRE, I_WEG, I_WEU, I_WED };

struct Frame {
    LAS unsigned char* lds;
    int tid, lane, wave, G, vcu;
    long gtid, gsz; int gw, ngw;
    const float* const* in; float* out; unsigned char* ws; gu32* ctl;
};

__host__ __device__ __forceinline__ int win_src_col(int c) {
    if (c < 256) return c;
    if (c < 512) { const int j = c - 256; return j < 160 ? 256 + j : -1; }
    if (c < 1024) return 928 + (c - 512);
    if (c < 1536) return 416 + (c - 1024);
    if (c < 2048) return 1440 + (c - 1536);
    if (c < 3072) return 1952 + (c - 2048);
    return 2976 + (c - 3072);
}

__device__ __forceinline__ void rms_row_to_bf16(const Frame& F, const float* xrow, const float* gain, bf16* orow) {
    const GAS f32x4* xr = (const GAS f32x4*)xrow + F.lane;
    const GAS f32x4* gr = (const GAS f32x4*)gain + F.lane;
    f32x4 v[4]; float s = 0.f;
#pragma unroll
    for (int j = 0; j < 4; ++j) { v[j] = xr[64 * j]; s += (v[j].x * v[j].x + v[j].y * v[j].y) + (v[j].z * v[j].z + v[j].w * v[j].w); }
    const float rs = 1.0f / sqrtf(wave_sum(s) * (1.f / DM) + EPS);
    GAS unsigned long long* o8 = (GAS unsigned long long*)orow + F.lane;
#pragma unroll
    for (int j = 0; j < 4; ++j) { const f32x4 g = gr[64 * j];
        o8[64 * j] = (unsigned long long)pk2(v[j].x * rs * g.x, v[j].y * rs * g.y) | ((unsigned long long)pk2(v[j].z * rs * g.z, v[j].w * rs * g.w) << 32); }
}
__device__ __forceinline__ void p0_prologue(const Frame& F) {
    bf16* XN = (bf16*)(F.ws + WS_XN);
    for (int m = F.gw; m < NTOK; m += F.ngw) rms_row_to_bf16(F, F.in[I_X] + (size_t)m * DM, F.in[I_NMIX], XN + (size_t)m * DM);
    float* cosm = (float*)(F.ws + WS_TAB + TB_COSM); float* sinm = (float*)(F.ws + WS_TAB + TB_SINM);
    float* cosd = (float*)(F.ws + WS_TAB + TB_COSD); float* sind = (float*)(F.ws + WS_TAB + TB_SIND);
    for (long i = F.gtid; i < SEQ * 16; i += F.gsz) { const int pos = (int)(i >> 4), f = (int)(i & 15);
        const float inv = 1.0f / powf(500000.0f, (float)(2 * f) / 32.0f); const float ang = (float)pos * inv;
        cosm[i] = cosf(ang); sinm[i] = sinf(ang); }
    for (long i = F.gtid; i < SEQ * 8; i += F.gsz) { const int pos = (int)(i >> 3), f = (int)(i & 7);
        const float inv = 1.0f / powf(500000.0f, (float)(2 * f) / 16.0f); const float ang = (float)pos * inv;
        cosd[i] = cosf(ang); sind[i] = sinf(ang); }
    if (F.gw == 0) {
        const float a = F.in[I_LQ1][F.lane] * F.in[I_LK1][F.lane], b = F.in[I_LQ2][F.lane] * F.in[I_LK2][F.lane];
        const float s1 = wave_sum(a), s2 = wave_sum(b);
        if (F.lane == 0) *(float*)(F.ws + WS_TAB + TB_LAM) = expf(s1) - expf(s2) + LAMBDA_INIT;
    }
}

__device__ __forceinline__ void p1_naive(const Frame& F) {
    const bf16* XN = (const bf16*)(F.ws + WS_XN); const float* W = F.in[I_WIN];
    for (long i = F.gtid; i < (long)NTOK * 4096; i += F.gsz) {
        const int tok = (int)(i >> 12), c = (int)(i & 4095), src = win_src_col(c);
        float acc = 0.f;
        if (src >= 0) { const bf16* xr = XN + (size_t)tok * DM;
            for (int k = 0; k < DM; ++k) acc += bf2f(xr[k]) * bfr(W[(size_t)k * INW + src]); }
        const int pn = c >> 8;
        if (pn < 8) { bf16* base = (bf16*)(F.ws + WS_LAT + (size_t)(pn >> 1) * 16 * MiB); base[(size_t)tok * 512 + (pn & 1) * 256 + (c & 255)] = (bf16)f2bf(acc); }
        else { bf16* base = (bf16*)(F.ws + WS_GM + (size_t)((pn - 8) >> 2) * 32 * MiB); const float sg = 1.0f / (1.0f + expf(-acc));
            base[(size_t)tok * 1024 + ((pn - 8) & 3) * 256 + (c & 255)] = (bf16)f2bf(sg); }
    }
}

__device__ __forceinline__ size_t km_index(int b, int h, int s, int d) { return ((((size_t)(b * 8 + h) * 64 + (s >> 6)) * 12 + (d >> 3)) * 64 + (s & 63)) * 8 + (d & 7); }
__device__ __forceinline__ size_t kd_index(int b, int hs, int s, int d) { return ((((size_t)(b * 8 + hs) * 64 + (s >> 6)) * 8 + (d >> 3)) * 64 + (s & 63)) * 8 + (d & 7); }
__device__ __forceinline__ float p2_dotq(const bf16* lat, const float* g, const float* W, int col) {
    float a = 0.f; for (int k = 0; k < 256; ++k) a += bf2f(lat[k]) * bfr(g[k] * W[(size_t)k * 768 + col]); return a; }
__device__ __forceinline__ float p2_dotkv(const bf16* lat, const float* g, const float* W, int col) {
    float a = 0.f; for (int k = 0; k < 128; ++k) a += bf2f(lat[k]) * bfr(g[k] * W[(size_t)k * 1024 + col]); return a; }
__device__ __forceinline__ void p2_naive(const Frame& F) {
    const bf16* LAT = (const bf16*)(F.ws + WS_LAT);
    const float* cosm = (const float*)(F.ws + WS_TAB + TB_COSM); const float* sinm = (const float*)(F.ws + WS_TAB + TB_SINM);
    const float* cosd = (const float*)(F.ws + WS_TAB + TB_COSD); const float* sind = (const float*)(F.ws + WS_TAB + TB_SIND);
    bf16* QM = (bf16*)(F.ws + WS_QM); bf16* KM = (bf16*)(F.ws + WS_KM); bf16* VM = (bf16*)(F.ws + WS_VM);
    for (long i = F.gtid; i < (long)NTOK * 8; i += F.gsz) {
        const int tok = (int)(i >> 3), h = (int)(i & 7), pos = tok & (SEQ - 1);
        const bf16* lat = LAT + (size_t)tok * 512; const float* g = F.in[I_QLN]; const float* W = F.in[I_WUQ]; const float* qg = F.in[I_QG];
        float sl = 0.f; for (int k = 0; k < 256; ++k) { const float v = bf2f(lat[k]); sl += v * v; }
        const float rs = 1.0f / sqrtf(sl * (1.f / 256.f) + EPS);
        float ss = 0.f; for (int d = 0; d < 96; ++d) { const float v = rs * p2_dotq(lat, g, W, h * 96 + d); ss += v * v; }
        const float rn = 1.0f / sqrtf(ss * (1.f / 96.f) + EPS);
        bf16* o = QM + ((size_t)tok * 8 + h) * 96;
        for (int d = 0; d < 64; ++d) o[d] = (bf16)f2bf(rs * p2_dotq(lat, g, W, h * 96 + d) * rn * qg[d] * QS_MLA);
        for (int f = 0; f < 16; ++f) {
            const float v1 = rs * p2_dotq(lat, g, W, h * 96 + 64 + f) * rn * qg[64 + f], v2 = rs * p2_dotq(lat, g, W, h * 96 + 80 + f) * rn * qg[80 + f];
            const float c = cosm[pos * 16 + f], s = sinm[pos * 16 + f];
            o[64 + f] = (bf16)f2bf((v1 * c - v2 * s) * QS_MLA); o[80 + f] = (bf16)f2bf((v2 * c + v1 * s) * QS_MLA); }
    }
    for (long i = F.gtid; i < (long)NTOK * 8; i += F.gsz) {
        const int tok = (int)(i >> 3), h = (int)(i & 7), pos = tok & (SEQ - 1), b = tok >> 12;
        const bf16* lat = LAT + (size_t)tok * 512 + 256; const bf16* kr = LAT + (size_t)tok * 512 + 384;
        const float* g = F.in[I_KVLN]; const float* W = F.in[I_WUKV]; const float* kg = F.in[I_KG];
        float sl = 0.f; for (int k = 0; k < 128; ++k) { const float v = bf2f(lat[k]); sl += v * v; }
        const float rs = 1.0f / sqrtf(sl * (1.f / 128.f) + EPS);
        float ss = 0.f; for (int d = 0; d < 64; ++d) { const float v = rs * p2_dotkv(lat, g, W, h * 128 + d); ss += v * v; }
        for (int d = 0; d < 32; ++d) { const float v = bf2f(kr[d]); ss += v * v; }
        const float rn = 1.0f / sqrtf(ss * (1.f / 96.f) + EPS);
        for (int d = 0; d < 64; ++d) KM[km_index(b, h, pos, d)] = (bf16)f2bf(rs * p2_dotkv(lat, g, W, h * 128 + d) * rn * kg[d]);
        for (int f = 0; f < 16; ++f) {
            const float v1 = bf2f(kr[f]) * rn * kg[64 + f], v2 = bf2f(kr[16 + f]) * rn * kg[80 + f];
            const float c = cosm[pos * 16 + f], s = sinm[pos * 16 + f];
            KM[km_index(b, h, pos, 64 + f)] = (bf16)f2bf(v1 * c - v2 * s); KM[km_index(b, h, pos, 80 + f)] = (bf16)f2bf(v2 * c + v1 * s); }
        bf16* vo = VM + ((size_t)(b * 8 + h) * SEQ + pos) * 64;
        for (int d = 0; d < 64; ++d) vo[d] = (bf16)f2bf(rs * p2_dotkv(lat, g, W, h * 128 + 64 + d));
    }
    bf16* DQ = (bf16*)(F.ws + WS_DQ); const bf16* DKR = (const bf16*)(F.ws + WS_DKR); bf16* KD = (bf16*)(F.ws + WS_KD);
    for (long i = F.gtid; i < (long)NTOK * 8; i += F.gsz) {
        const int tok = (int)(i >> 3), hs = (int)(i & 7), pos = tok & (SEQ - 1), b = tok >> 12;
        {   bf16* q = DQ + (size_t)tok * 512 + hs * 64; const float* g = F.in[I_DQG];
            float ss = 0.f; for (int d = 0; d < 64; ++d) { const float v = bf2f(q[d]); ss += v * v; }
            const float rn = 1.0f / sqrtf(ss * (1.f / 64.f) + EPS);
            for (int f = 0; f < 8; ++f) { const float v1 = bf2f(q[f]) * rn * g[f], v2 = bf2f(q[8 + f]) * rn * g[8 + f];
                const float c = cosd[pos * 8 + f], s = sind[pos * 8 + f];
                q[f] = (bf16)f2bf((v1 * c - v2 * s) * QS_DIFF); q[8 + f] = (bf16)f2bf((v2 * c + v1 * s) * QS_DIFF); }
            for (int d = 16; d < 64; ++d) q[d] = (bf16)f2bf(bf2f(q[d]) * rn * g[d] * QS_DIFF); }
        {   const bf16* k = DKR + (size_t)tok * 512 + hs * 64; const float* g = F.in[I_DKG];
            float ss = 0.f; for (int d = 0; d < 64; ++d) { const float v = bf2f(k[d]); ss += v * v; }
            const float rn = 1.0f / sqrtf(ss * (1.f / 64.f) + EPS);
            for (int f = 0; f < 8; ++f) { const float v1 = bf2f(k[f]) * rn * g[f], v2 = bf2f(k[8 + f]) * rn * g[8 + f];
                const float c = cosd[pos * 8 + f], s = sind[pos * 8 + f];
                KD[kd_index(b, hs, pos, f)] = (bf16)f2bf(v1 * c - v2 * s); KD[kd_index(b, hs, pos, 8 + f)] = (bf16)f2bf(v2 * c + v1 * s); }
            for (int d = 16; d < 64; ++d) KD[kd_index(b, hs, pos, d)] = (bf16)f2bf(bf2f(k[d]) * rn * g[d]); }
    }
}

__device__ __forceinline__ void p3_naive(const Frame& F) {
    volatile LAS float* qs = (volatile LAS float*)(F.lds + F.wave * 1024);
    volatile LAS float* ps = qs + 128;
    const bf16* QM = (const bf16*)(F.ws + WS_QM); const bf16* KM = (const bf16*)(F.ws + WS_KM); const bf16* VM = (const bf16*)(F.ws + WS_VM);
    const bf16* QD = (const bf16*)(F.ws + WS_DQ); const bf16* KD = (const bf16*)(F.ws + WS_KD); const bf16* DV = (const bf16*)(F.ws + WS_DV);
    bf16* OM = (bf16*)(F.ws + WS_OM); bf16* OD = (bf16*)(F.ws + WS_OD);
    const int lane = F.lane;
    for (long task = F.gw; task < 2L * NTOK * 8; task += F.ngw) {
        const int kind = (int)(task / ((long)NTOK * 8)); const int r = (int)(task % ((long)NTOK * 8));
        const int tok = r >> 3, hh = r & 7, b = tok >> 12, s = tok & (SEQ - 1);
        const int DQK = kind == 0 ? 96 : 64, NCH = DQK / 8;
        const bf16* q = kind == 0 ? QM + ((size_t)tok * 8 + hh) * 96 : QD + ((size_t)tok * 8 + hh) * 64;
        __builtin_amdgcn_wave_barrier();
        for (int d = lane; d < DQK; d += 64) qs[d] = bf2f(q[d]);
        __builtin_amdgcn_wave_barrier();
        const int ntile = (s >> 6) + 1;
        float m = -1e30f, l = 0.f, o0 = 0.f, o1 = 0.f;
        for (int t = 0; t < ntile; ++t) {
            const bf16* Kb = kind == 0 ? KM + ((size_t)(b * 8 + hh) * 64 + t) * 12 * 512 : KD + ((size_t)(b * 8 + hh) * 64 + t) * 8 * 512;
            float sc = 0.f;
            for (int c = 0; c < NCH; ++c) { const v4u kk = *(const GAS v4u*)(Kb + c * 512 + lane * 8);
                sc += qs[8 * c + 0] * bf2f(kk.x) + qs[8 * c + 1] * bf2f(kk.x >> 16) + qs[8 * c + 2] * bf2f(kk.y) + qs[8 * c + 3] * bf2f(kk.y >> 16)
                    + qs[8 * c + 4] * bf2f(kk.z) + qs[8 * c + 5] * bf2f(kk.z >> 16) + qs[8 * c + 6] * bf2f(kk.w) + qs[8 * c + 7] * bf2f(kk.w >> 16); }
            const float mn = fmaxf(m, wave_max(sc)); const float alpha = exp2f(m - mn); const float p = exp2f(sc - mn);
            __builtin_amdgcn_wave_barrier(); ps[lane] = p; __builtin_amdgcn_wave_barrier();
            l = l * alpha + wave_sum(p); o0 *= alpha; o1 *= alpha; m = mn;
            if (kind == 0) { const bf16* vb = VM + ((size_t)(b * 8 + hh) * SEQ + t * 64) * 64 + lane;
                for (int j = 0; j < 64; ++j) o0 += ps[j] * bf2f(vb[(size_t)j * 64]); }
            else { const bf16* vb = DV + ((size_t)(b * SEQ + t * 64)) * 512 + (hh >> 1) * 128 + lane;
                for (int j = 0; j < 64; ++j) { const float pj = ps[j]; o0 += pj * bf2f(vb[(size_t)j * 512]); o1 += pj * bf2f(vb[(size_t)j * 512 + 64]); } }
        }
        const float il = 1.0f / l;
        if (kind == 0) OM[(size_t)tok * 512 + hh * 64 + lane] = (bf16)f2bf(o0 * il);
        else { bf16* o = OD + ((size_t)tok * 8 + hh) * 128; o[lane] = (bf16)f2bf(o0 * il); o[lane + 64] = (bf16)f2bf(o1 * il); }
    }
}

__device__ __forceinline__ void p3b_combine(const Frame& F) {
    const bf16* OD = (const bf16*)(F.ws + WS_OD); bf16* ODN = (bf16*)(F.ws + WS_ODN);
    const float lam = *(const float*)(F.ws + WS_TAB + TB_LAM);
    const int h = F.lane >> 4, c = F.lane & 15;
    float g[8];
#pragma unroll
    for (int j = 0; j < 8; ++j) g[j] = F.in[I_SUBLN][c * 8 + j] * (1.0f - LAMBDA_INIT);
    for (int tok = F.gw; tok < NTOK; tok += F.ngw) {
        const v4u a = *(const GAS v4u*)(OD + ((size_t)tok * 8 + 2 * h) * 128 + c * 8);
        const v4u b = *(const GAS v4u*)(OD + ((size_t)tok * 8 + 2 * h + 1) * 128 + c * 8);
        float o[8];
        o[0] = bf2f(a.x) - lam * bf2f(b.x); o[1] = bf2f(a.x >> 16) - lam * bf2f(b.x >> 16);
        o[2] = bf2f(a.y) - lam * bf2f(b.y); o[3] = bf2f(a.y >> 16) - lam * bf2f(b.y >> 16);
        o[4] = bf2f(a.z) - lam * bf2f(b.z); o[5] = bf2f(a.z >> 16) - lam * bf2f(b.z >> 16);
        o[6] = bf2f(a.w) - lam * bf2f(b.w); o[7] = bf2f(a.w >> 16) - lam * bf2f(b.w >> 16);
        float ss = 0.f;
#pragma unroll
        for (int j = 0; j < 8; ++j) ss += o[j] * o[j];
        ss += __shfl_xor(ss, 1); ss += __shfl_xor(ss, 2); ss += __shfl_xor(ss, 4); ss += __shfl_xor(ss, 8);
        const float rn = 1.0f / sqrtf(ss * (1.f / 128.f) + EPS);
        v4u w; w.x = pk2(o[0] * rn * g[0], o[1] * rn * g[1]); w.y = pk2(o[2] * rn * g[2], o[3] * rn * g[3]);
        w.z = pk2(o[4] * rn * g[4], o[5] * rn * g[5]); w.w = pk2(o[6] * rn * g[6], o[7] * rn * g[7]);
        *(GAS v4u*)(ODN + (size_t)tok * 512 + h * 128 + c * 8) = w;
    }
}

__device__ __forceinline__ void p4_naive(const Frame& F) {
    const bf16* OM = (const bf16*)(F.ws + WS_OM); const bf16* ODN = (const bf16*)(F.ws + WS_ODN);
    const bf16* GM = (const bf16*)(F.ws + WS_GM); const bf16* GD = (const bf16*)(F.ws + WS_GD); bf16* MG = (bf16*)(F.ws + WS_MG);
    const float* Wm = F.in[I_WMU]; const float* Wd = F.in[I_WDU];
    for (long i = F.gtid; i < (long)NTOK * 1024; i += F.gsz) {
        const int tok = (int)(i >> 10), n = (int)(i & 1023);
        float um = 0.f, ud = 0.f;
        for (int k = 0; k < 512; ++k) { um += bf2f(OM[(size_t)tok * 512 + k]) * bfr(Wm[(size_t)k * 1024 + n]); ud += bf2f(ODN[(size_t)tok * 512 + k]) * bfr(Wd[(size_t)k * 1024 + n]); }
        MG[i] = (bf16)f2bf(bf2f(GM[i]) * um + bf2f(GD[i]) * ud);
    }
}
__device__ __forceinline__ void p5_naive(const Frame& F) {
    const bf16* MG = (const bf16*)(F.ws + WS_MG); const float* W = F.in[I_WOUT];
    for (long i = F.gtid; i < (long)NTOK * 1024; i += F.gsz) {
        const int tok = (int)(i >> 10), n = (int)(i & 1023);
        float a = 0.f; for (int k = 0; k < 1024; ++k) a += bf2f(MG[(size_t)tok * 1024 + k]) * bfr(W[(size_t)k * 1024 + n]);
        F.out[i] = F.in[I_X][i] + a;
    }
}

__device__ __forceinline__ void p6_router(const Frame& F) {
    bf16* H2 = (bf16*)(F.ws + WS_XN);
    int* toke = (int*)(F.ws + WS_TAB + TB_TOKE); float* tokw = (float*)(F.ws + WS_TAB + TB_TOKW);
    const float* wrg = F.in[I_WRG]; const float* wre = F.in[I_WRE];
    for (int tok = F.gw; tok < NTOK; tok += F.ngw) {
        const GAS f32x4* xr = (const GAS f32x4*)(F.out + (size_t)tok * DM) + F.lane;
        const GAS f32x4* gr = (const GAS f32x4*)F.in[I_NFFN] + F.lane;
        f32x4 v[4]; float s = 0.f;
#pragma unroll
        for (int j = 0; j < 4; ++j) { v[j] = xr[64 * j]; s += (v[j].x * v[j].x + v[j].y * v[j].y) + (v[j].z * v[j].z + v[j].w * v[j].w); }
        const float rs = 1.0f / sqrtf(wave_sum(s) * (1.f / DM) + EPS);
        GAS unsigned long long* o8 = (GAS unsigned long long*)(H2 + (size_t)tok * DM) + F.lane;
        float acc[36];
#pragma unroll
        for (int n = 0; n < 36; ++n) acc[n] = 0.f;
#pragma unroll
        for (int j = 0; j < 4; ++j) { const f32x4 g = gr[64 * j]; f32x4 h; h.x = v[j].x * rs * g.x; h.y = v[j].y * rs * g.y; h.z = v[j].z * rs * g.z; h.w = v[j].w * rs * g.w;
            o8[64 * j] = (unsigned long long)pk2(h.x, h.y) | ((unsigned long long)pk2(h.z, h.w) << 32);
#pragma unroll
            for (int e = 0; e < 4; ++e) { const int k = 4 * F.lane + 256 * j + e; const float hk = h[e];
                const f32x4 wg = *(const GAS f32x4*)(wrg + (size_t)k * 4);
                acc[0] += hk * wg.x; acc[1] += hk * wg.y; acc[2] += hk * wg.z; acc[3] += hk * wg.w;
#pragma unroll
                for (int q = 0; q < 8; ++q) { const f32x4 we = *(const GAS f32x4*)(wre + (size_t)k * 32 + 4 * q);
                    acc[4 + 4 * q] += hk * we.x; acc[5 + 4 * q] += hk * we.y; acc[6 + 4 * q] += hk * we.z; acc[7 + 4 * q] += hk * we.w; } } }
#pragma unroll
        for (int n = 0; n < 36; ++n) acc[n] = wave_sum(acc[n]);
        float gl[4];
#pragma unroll
        for (int n = 0; n < 4; ++n) gl[n] = acc[n] + F.in[I_BRG][n];
        int g = 0; float gm = gl[0];
#pragma unroll
        for (int n = 1; n < 4; ++n) if (gl[n] > gm) { gm = gl[n]; g = n; }
        float gsum = 0.f;
#pragma unroll
        for (int n = 0; n < 4; ++n) gsum += expf(gl[n] - gm);
        const float pg = 1.0f / gsum;
        float el[8];
#pragma unroll
        for (int n = 0; n < 8; ++n) el[n] = (g == 0 ? acc[4 + n] : g == 1 ? acc[12 + n] : g == 2 ? acc[20 + n] : acc[28 + n]) + F.in[I_BRE][8 * g + n];
        int i1 = 0; float l1 = el[0];
#pragma unroll
        for (int n = 1; n < 8; ++n) if (el[n] > l1) { l1 = el[n]; i1 = n; }
        int i2 = -1; float l2 = -3.0e38f;
#pragma unroll
        for (int n = 0; n < 8; ++n) if (n != i1 && el[n] > l2) { l2 = el[n]; i2 = n; }
        const float p2 = expf(l2 - l1); const float w1 = pg / (1.0f + p2), w2 = pg * p2 / (1.0f + p2);
        if (F.lane == 0) { toke[2 * tok] = 8 * g + i1; toke[2 * tok + 1] = 8 * g + i2; tokw[2 * tok] = w1; tokw[2 * tok + 1] = w2; }
    }
}

__device__ __forceinline__ void p7a_naive(const Frame& F) {
    const bf16* H2 = (const bf16*)(F.ws + WS_XN); bf16* HN = (bf16*)(F.ws + WS_H2N); const int* toke = (const int*)(F.ws + WS_TAB + TB_TOKE);
    for (long i = F.gtid; i < (long)NTOK * 2 * 256; i += F.gsz) {
        const int ts = (int)(i >> 8), j = (int)(i & 255), tok = ts >> 1, e = toke[ts];
        const float* Wg = F.in[I_WEG] + (size_t)e * 1024 * 256; const float* Wu = F.in[I_WEU] + (size_t)e * 1024 * 256;
        float g = 0.f, u = 0.f;
        for (int k = 0; k < 1024; ++k) { const float h = bf2f(H2[(size_t)tok * 1024 + k]); g += h * bfr(Wg[(size_t)k * 256 + j]); u += h * bfr(Wu[(size_t)k * 256 + j]); }
        HN[i] = (bf16)f2bf(g / (1.0f + expf(-g)) * u);
    }
}
__device__ __forceinline__ void p7b_naive(const Frame& F) {
    const bf16* HN = (const bf16*)(F.ws + WS_H2N); bf16* Y = (bf16*)(F.ws + WS_Y);
    const int* toke = (const int*)(F.ws + WS_TAB + TB_TOKE); const float* tokw = (const float*)(F.ws + WS_TAB + TB_TOKW);
    for (long i = F.gtid; i < (long)NTOK * 2 * 1024; i += F.gsz) {
        const int ts = (int)(i >> 10), n = (int)(i & 1023), tok = ts >> 1, slot = ts & 1, e = toke[ts];
        const float* Wd = F.in[I_WED] + (size_t)e * 256 * 1024;
        float a = 0.f; for (int k = 0; k < 256; ++k) a += bf2f(HN[(size_t)ts * 256 + k]) * bfr(Wd[(size_t)k * 1024 + n]);
        Y[((size_t)slot * NTOK + tok) * 1024 + n] = (bf16)f2bf(tokw[ts] * a);
    }
}
__device__ __forceinline__ void p8_final(const Frame& F) {
    const bf16* Y = (const bf16*)(F.ws + WS_Y);
    for (long i = F.gtid; i < (long)NTOK * 256; i += F.gsz) {
        const f32x4 x = *(const GAS f32x4*)(F.out + 4 * i);
        const v2u a = *(const GAS v2u*)(Y + 4 * i), b = *(const GAS v2u*)(Y + (size_t)NTOK * 1024 + 4 * i);
        f32x4 o; o.x = x.x + bf2f(a.x) + bf2f(b.x); o.y = x.y + bf2f(a.x >> 16) + bf2f(b.x >> 16);
        o.z = x.z + bf2f(a.y) + bf2f(b.y); o.w = x.w + bf2f(a.y >> 16) + bf2f(b.y >> 16);
        *(GAS f32x4*)(F.out + 4 * i) = o;
    }
}

constexpr int NPH = 11;
__global__ void __launch_bounds__(NWAVES * 64, 2) fwd_kernel(Args args) {
    extern __shared__ __attribute__((aligned(16))) unsigned char lds[];
    Frame F;
    F.lds = (LAS unsigned char*)lds;
    F.tid = threadIdx.x; F.lane = F.tid & 63; F.wave = __builtin_amdgcn_readfirstlane(F.tid >> 6);
    F.G = gridDim.x; { const int bx = blockIdx.x; F.vcu = (F.G % 8 == 0) ? (bx % 8) * (F.G / 8) + bx / 8 : bx; }
    F.gtid = (long)blockIdx.x * (NWAVES * 64) + F.tid; F.gsz = (long)F.G * (NWAVES * 64);
    F.gw = blockIdx.x * NWAVES + F.wave; F.ngw = F.G * NWAVES;
    F.in = args.in; F.out = args.out; F.ws = args.ws; F.ctl = (gu32*)(args.ws + WS_CTL);
    for (int u = F.tid; u < (LDS_BYTES - LDSCTL_OFF) / 4; u += NWAVES * 64) ((LAS unsigned*)(F.lds + LDSCTL_OFF))[u] = 0u;
    __syncthreads();
    const int lo = args.ph_lo, hi = args.ph_hi;
    const bool multi = (hi - lo) > 1;
    XcdBarrier bar; bar.bar = (unsigned*)(F.ctl + CW_BAR); bar.x = 0; bar.st = nullptr;
    if (multi) bar = xcd_barrier_post((unsigned*)(F.ctl + CW_BAR), (volatile LAS unsigned*)(F.lds + MISC_OFF) + 8);
#define IN(k) (lo <= (k) && (k) < hi)
#define SEAM(k) do { if (IN(k) && IN((k) + 1)) xcd_barrier(bar); } while (0)
    if (IN(0)) { p0_prologue(F); } SEAM(0);
    if (IN(1)) { p1_naive(F); } SEAM(1);
    if (IN(2)) { p2_naive(F); } SEAM(2);
    if (IN(3)) { p3_naive(F); } SEAM(3);
    if (IN(4)) { p3b_combine(F); } SEAM(4);
    if (IN(5)) { p4_naive(F); } SEAM(5);
    if (IN(6)) { p5_naive(F); } SEAM(6);
    if (IN(7)) { p6_router(F); } SEAM(7);
    if (IN(8)) { p7a_naive(F); } SEAM(8);
    if (IN(9)) { p7b_naive(F); } SEAM(9);
    if (IN(10)) { p8_final(F); }
#undef IN
#undef SEAM
}

extern "C" void kernel_launch(void* const* d_in, const int* in_sizes, int n_in, void* d_out, int out_size, void* d_ws, size_t ws_size, hipStream_t stream) {
    static int grid = 0;
    if (grid == 0) {
        if (n_in != 27 || out_size != NTOK * DM || ws_size < WS_END) { fprintf(stderr, "kernel_launch: unexpected problem shape (n_in %d out %d ws %zu)\n", n_in, out_size, ws_size); grid = -1; return; }
        int dev = 0, cus = 0, per_cu = 0;
        if (hipGetDevice(&dev) != hipSuccess || hipDeviceGetAttribute(&cus, hipDeviceAttributeMultiprocessorCount, dev) != hipSuccess) { grid = -1; return; }
        if (hipFuncSetAttribute((const void*)fwd_kernel, hipFuncAttributeMaxDynamicSharedMemorySize, LDS_BYTES) != hipSuccess) { fprintf(stderr, "kernel_launch: hipFuncSetAttribute failed\n"); grid = -1; return; }
        if (hipOccupancyMaxActiveBlocksPerMultiprocessor(&per_cu, (const void*)fwd_kernel, NWAVES * 64, LDS_BYTES) != hipSuccess || per_cu < 1) { fprintf(stderr, "kernel_launch: occupancy query says %d\n", per_cu); per_cu = 1; }
        (void)hipGetLastError();
        grid = cus;
    }
    if (grid < 0) return;
    (void)hipMemsetAsync((char*)d_ws + WS_CTL, 0, CTL_ZERO_BYTES, stream);
    Args a{};
    for (int i = 0; i < 27; ++i) a.in[i] = (const float*)d_in[i];
    a.out = (float*)d_out; a.ws = (unsigned char*)d_ws;
#if MK_N_LAUNCHES == 1
    a.ph_lo = 0; a.ph_hi = NPH; a.li = 0;
    hipLaunchKernelGGL(fwd_kernel, dim3(grid), dim3(NWAVES * 64), LDS_BYTES, stream, a);
#else
    for (int p = 0; p < NPH; ++p) { a.ph_lo = p; a.ph_hi = p + 1; a.li = p;
        hipLaunchKernelGGL(fwd_kernel, dim3(grid), dim3(NWAVES * 64), LDS_BYTES, stream, a); }
#endif
}
```

```cpp
#include <hip/hip_runtime.h>
#include <cstdio>
#include <cstdint>

#ifndef MK_N_LAUNCHES
#define MK_N_LAUNCHES 1
#endif

constexpr int BATCH = 4, SEQ = 4096, DM = 1024, NTOK = BATCH * SEQ;
constexpr int INW = 4000;
constexpr float EPS = 1e-6f;
constexpr float LOG2E = 1.4426950408889634f;
constexpr float QS_MLA = 0.10206207261596577f * LOG2E;
constexpr float QS_DIFF = 0.125f * LOG2E;
constexpr float LAMBDA_INIT = 0.2f;
constexpr int NEXP = 32;

constexpr size_t MiB = 1u << 20;
constexpr size_t WS_CTL = 0, CTL_ZERO_BYTES = 1 * MiB;
constexpr size_t WS_WINT = 1 * MiB;
constexpr size_t WS_WUQT = 9 * MiB, WS_WUKVT = 9 * MiB + 512 * 1024;
constexpr size_t WS_WMUT = 10 * MiB, WS_WDUT = 11 * MiB, WS_WOUTT = 12 * MiB;
constexpr size_t WS_WGUT = 48 * MiB;
constexpr size_t WS_WDT = 80 * MiB;
constexpr size_t WS_LIST = 96 * MiB;
constexpr size_t WS_HS = 176 * MiB;
constexpr size_t WS_T = 48 * MiB;
constexpr size_t WS_TAB = 14 * MiB;
constexpr size_t WS_XN = 16 * MiB;
constexpr size_t WS_QM = 16 * MiB;
constexpr size_t WS_LAT = 48 * MiB;
constexpr size_t WS_DKR = 64 * MiB;
constexpr size_t WS_DQ = 80 * MiB;
constexpr size_t WS_DV = 96 * MiB;
constexpr size_t WS_GM = 112 * MiB;
constexpr size_t WS_GD = 144 * MiB;
constexpr size_t WS_KM = 176 * MiB;
constexpr size_t WS_VM = 200 * MiB;
constexpr size_t WS_KD = 216 * MiB;
constexpr size_t WS_OM = 232 * MiB;
constexpr size_t WS_OD = 48 * MiB;
constexpr size_t WS_ODN = 176 * MiB;
constexpr size_t WS_MG = 192 * MiB;
constexpr size_t WS_H2N = 176 * MiB;
constexpr size_t WS_Y = 112 * MiB;
constexpr size_t WS_END = 256 * MiB;

constexpr size_t TB_COSM = 0, TB_SINM = 256 * 1024, TB_COSD = 512 * 1024, TB_SIND = 640 * 1024, TB_LAM = 768 * 1024;
constexpr size_t TB_TOKE = 832 * 1024;
constexpr size_t TB_TOKW = 960 * 1024;

constexpr int CW_BAR = 4096;
constexpr int CW_CNT = 1024;

constexpr int LDS_BYTES = 147456;
constexpr int RING_BYTES = 131072;
constexpr int LDSCTL_OFF = RING_BYTES, MISC_OFF = LDSCTL_OFF + 320;
constexpr int NWAVES = 8;
constexpr int MOE_TAB_OFF = LDSCTL_OFF + 1024;

#define GAS __attribute__((address_space(1)))
#define LAS __attribute__((address_space(3)))
typedef unsigned short bf16;
typedef unsigned v4u __attribute__((ext_vector_type(4)));
typedef unsigned v2u __attribute__((ext_vector_type(2)));
typedef float f32x4 __attribute__((ext_vector_type(4)));
typedef GAS unsigned gu32;

__device__ __forceinline__ unsigned f2bf(float f) { unsigned u = __builtin_bit_cast(unsigned, f); return (u + 0x7fffu + ((u >> 16) & 1u)) >> 16; }
__device__ __forceinline__ float bf2f(unsigned b) { return __builtin_bit_cast(float, (b & 0xffffu) << 16); }
__device__ __forceinline__ float bfr(float f) { return bf2f(f2bf(f)); }
__device__ __forceinline__ unsigned pk2(float lo, float hi) { return f2bf(lo) | (f2bf(hi) << 16); }
__device__ __forceinline__ float wave_sum(float v) {
#pragma unroll
    for (int o = 1; o < 64; o <<= 1) v += __shfl_xor(v, o);
    return v;
}
__device__ __forceinline__ float wave_max(float v) {
#pragma unroll
    for (int o = 1; o < 64; o <<= 1) v = fmaxf(v, __shfl_xor(v, o));
    return v;
}

#define XB_TMO      128
#define XB_XCNT(j)  (256  + 64 * (j))
#define XB_XSUB(j)  (1280 + 64 * (j))
#define XB_XGEN(j)  (2304 + 64 * (j))
#define XB_TOP      3328
#define XB_TOPGEN   3392
#define XCD_BAR_WORDS 3456
#define XB_SPIN_CAP (1u << 22)
__device__ __forceinline__ unsigned xb_ld(unsigned* p)              { return __hip_atomic_load(p, __ATOMIC_RELAXED, __HIP_MEMORY_SCOPE_AGENT); }
__device__ __forceinline__ unsigned xb_add(unsigned* p, unsigned v) { return __hip_atomic_fetch_add(p, v, __ATOMIC_RELAXED, __HIP_MEMORY_SCOPE_AGENT); }
__device__ __forceinline__ unsigned xb_xcc_id() { return (unsigned)__builtin_amdgcn_s_getreg((3 << 11) | 20) & 0xFu; }
#define XB_SPIN(cond, bar) do { unsigned _sp = 0; while (cond) { __builtin_amdgcn_s_sleep(1); \
    if ((++_sp & 255u) == 0u) { if (xb_ld(&(bar)[XB_TMO])) break; if (_sp > XB_SPIN_CAP) { atomicAdd(&(bar)[XB_TMO], 1u); break; } } } } while (0)
struct XcdBarrier { unsigned* bar; unsigned x; volatile LAS unsigned* st; };
__device__ __forceinline__ XcdBarrier xcd_barrier_post(unsigned* bar, volatile LAS unsigned* st) {
    XcdBarrier b; b.bar = bar; b.x = xb_xcc_id(); b.st = st;
    if (threadIdx.x == 0) (void)xb_add(&bar[XB_XCNT(b.x)], 1u);
    return b;
}
__device__ __forceinline__ void xcd_barrier_complete(unsigned* bar, unsigned x, unsigned& nloc, unsigned& nx) {
    const unsigned G = gridDim.x * gridDim.y * gridDim.z;
    unsigned sum, cnt, mine, sp = 0u;
    for (;;) {
        sum = 0u; cnt = 0u; mine = 0u;
#pragma unroll
        for (unsigned j = 0; j < 16; ++j) { const unsigned c = xb_ld(&bar[XB_XCNT(j)]); sum += c; cnt += (c > 0u) ? 1u : 0u; mine = (j == x) ? c : mine; }
        if (sum == G) break;
        __builtin_amdgcn_s_sleep(1);
        if ((++sp & 255u) == 0u) { if (xb_ld(&bar[XB_TMO])) break; if (sp > XB_SPIN_CAP) { atomicAdd(&bar[XB_TMO], 1u); break; } }
    }
    nloc = mine > 0u ? mine : 1u; nx = cnt > 0u ? cnt : 1u;
}
__device__ __forceinline__ void xcd_barrier(const XcdBarrier& b) {
    asm volatile("s_waitcnt vmcnt(0)" ::: "memory");
    __syncthreads();
    if (threadIdx.x == 0) {
        unsigned* bar = b.bar;
        __builtin_amdgcn_s_waitcnt(0);
        unsigned nloc = b.st[0], nx = b.st[1];
        if (nloc == 0u) { xcd_barrier_complete(bar, b.x, nloc, nx); b.st[0] = nloc; b.st[1] = nx; }
        const unsigned old = xb_add(&bar[XB_XSUB(b.x)], 1u);
        const unsigned gen = old / nloc;
        if (old + 1u == (gen + 1u) * nloc) {
            __builtin_amdgcn_fence(__ATOMIC_RELEASE, "agent");
            asm volatile("s_waitcnt vmcnt(0)" ::: "memory");
            const unsigned og = xb_add(&bar[XB_TOP], 1u);
            const unsigned tg = og / nx;
            if (og + 1u == (tg + 1u) * nx) xb_add(&bar[XB_TOPGEN], 1u);
            else XB_SPIN(xb_ld(&bar[XB_TOPGEN]) == tg, bar);
            __builtin_amdgcn_fence(__ATOMIC_ACQUIRE, "agent");
            xb_add(&bar[XB_XGEN(b.x)], 1u);
            asm volatile("s_waitcnt vmcnt(0)" ::: "memory");
        } else {
            XB_SPIN(xb_ld(&bar[XB_XGEN(b.x)]) == gen, bar);
            __builtin_amdgcn_fence(__ATOMIC_ACQUIRE, "agent");
            asm volatile("s_waitcnt vmcnt(0)" ::: "memory");
        }
    }
    __syncthreads();
}

struct Args { const float* in[27]; float* out; unsigned char* ws; int ph_lo, ph_hi, li, pad; };
enum { I_X = 0, I_NMIX, I_WIN, I_QLN, I_WUQ, I_KVLN, I_WUKV, I_QG, I_KG, I_DQG, I_DKG, I_LQ1, I_LK1, I_LQ2, I_LK2, I_SUBLN,
       I_WMU, I_WDU, I_WOUT, I_NFFN, I_WRG, I_BRG, I_WRE, I_BRE, I_WEG, I_WEU, I_WED };

struct Frame {
    LAS unsigned char* lds;
    int tid, lane, wave, G, vcu;
    const float* const* in; float* out; unsigned char* ws; gu32* ctl;
};

#define GTID ((long)blockIdx.x * (NWAVES * 64) + threadIdx.x)
#define GSZ ((long)gridDim.x * (NWAVES * 64))
#define GW ((int)(blockIdx.x * NWAVES + __builtin_amdgcn_readfirstlane(threadIdx.x >> 6)))
#define NGW ((int)(gridDim.x * NWAVES))
__host__ __device__ __forceinline__ int win_src_col(int c) {
    if (c < 256) return c;
    if (c < 512) { const int j = c - 256; return j < 160 ? 256 + j : -1; }
    if (c < 1024) return 928 + (c - 512);
    if (c < 1536) return 416 + (c - 1024);
    if (c < 2048) return 1440 + (c - 1536);
    if (c < 3072) return 1952 + (c - 2048);
    return 2976 + (c - 3072);
}

__device__ __forceinline__ void rms_row_to_bf16(const Frame& F, const float* xrow, const float* gain, bf16* orow) {
    const GAS f32x4* xr = (const GAS f32x4*)xrow + F.lane;
    const GAS f32x4* gr = (const GAS f32x4*)gain + F.lane;
    f32x4 v[4]; float s = 0.f;
#pragma unroll
    for (int j = 0; j < 4; ++j) { v[j] = xr[64 * j]; s += (v[j].x * v[j].x + v[j].y * v[j].y) + (v[j].z * v[j].z + v[j].w * v[j].w); }
    const float rs = 1.0f / sqrtf(wave_sum(s) * (1.f / DM) + EPS);
    GAS unsigned long long* o8 = (GAS unsigned long long*)orow + F.lane;
#pragma unroll
    for (int j = 0; j < 4; ++j) { const f32x4 g = gr[64 * j];
        o8[64 * j] = (unsigned long long)pk2(v[j].x * rs * g.x, v[j].y * rs * g.y) | ((unsigned long long)pk2(v[j].z * rs * g.z, v[j].w * rs * g.w) << 32); }
}
__device__ __forceinline__ void p0_prologue(const Frame& F) {
    bf16* XN = (bf16*)(F.ws + WS_XN);
    for (int m = GW; m < NTOK; m += NGW) rms_row_to_bf16(F, F.in[I_X] + (size_t)m * DM, F.in[I_NMIX], XN + (size_t)m * DM);
    float* cosm = (float*)(F.ws + WS_TAB + TB_COSM); float* sinm = (float*)(F.ws + WS_TAB + TB_SINM);
    float* cosd = (float*)(F.ws + WS_TAB + TB_COSD); float* sind = (float*)(F.ws + WS_TAB + TB_SIND);
    for (long i = GTID; i < SEQ * 16; i += GSZ) { const int pos = (int)(i >> 4), f = (int)(i & 15);
        const float inv = 1.0f / powf(500000.0f, (float)(2 * f) / 32.0f); const float ang = (float)pos * inv;
        cosm[i] = cosf(ang); sinm[i] = sinf(ang); }
    for (long i = GTID; i < SEQ * 8; i += GSZ) { const int pos = (int)(i >> 3), f = (int)(i & 7);
        const float inv = 1.0f / powf(500000.0f, (float)(2 * f) / 16.0f); const float ang = (float)pos * inv;
        cosd[i] = cosf(ang); sind[i] = sinf(ang); }
    if (GW == 0) {
        const float a = F.in[I_LQ1][F.lane] * F.in[I_LK1][F.lane], b = F.in[I_LQ2][F.lane] * F.in[I_LK2][F.lane];
        const float s1 = wave_sum(a), s2 = wave_sum(b);
        if (F.lane == 0) *(float*)(F.ws + WS_TAB + TB_LAM) = expf(s1) - expf(s2) + LAMBDA_INIT;
    }
}


__device__ __forceinline__ void cvt_item(const float* W, int ldw, int n0s, int k0, bf16* WT, int K, int n0d, const float* kscale, LAS float* scr, int lane) {
#pragma unroll 8
    for (int i = 0; i < 32; ++i) { const int kk = 2 * i + (lane >> 5); float v = n0s >= 0 ? W[(size_t)(k0 + kk) * ldw + n0s + (lane & 31)] : 0.f;
        if (kscale) v *= kscale[k0 + kk]; scr[kk * 33 + (lane & 31)] = v; }
    asm volatile("s_waitcnt lgkmcnt(0)" ::: "memory");
    const int c = lane & 7;
#pragma unroll
    for (int j = 0; j < 4; ++j) { const int n = (lane >> 3) + 8 * j; const LAS float* s = scr + (8 * c) * 33 + n;
        v4u o; o.x = pk2(s[0 * 33], s[1 * 33]); o.y = pk2(s[2 * 33], s[3 * 33]); o.z = pk2(s[4 * 33], s[5 * 33]); o.w = pk2(s[6 * 33], s[7 * 33]);
        *(GAS v4u*)(WT + (size_t)(n0d + n) * K + k0 + 8 * c) = o; }
    asm volatile("s_waitcnt lgkmcnt(0)" ::: "memory");
}
__device__ __forceinline__ void p0_weights(const Frame& F) {
    LAS float* scr = (LAS float*)(F.lds + F.wave * 16384);
    constexpr int I_IN = 16 * 128, I_MU = 8 * 32, I_DU = 8 * 32, I_OUT = 16 * 32, I_UQ = 4 * 24, I_UKV = 2 * 32, NITEMS = I_IN + I_MU + I_DU + I_OUT + I_UQ + I_UKV;
    for (int it = GW; it < NITEMS; it += NGW) {
        int r = it;
        if (r < I_IN) { const int kb = r / 128, nb = r % 128; cvt_item(F.in[I_WIN], INW, win_src_col(32 * nb), 64 * kb, (bf16*)(F.ws + WS_WINT), 1024, 32 * nb, nullptr, scr, F.lane); continue; } r -= I_IN;
        if (r < I_MU) { const int kb = r / 32, nb = r % 32; cvt_item(F.in[I_WMU], 1024, 32 * nb, 64 * kb, (bf16*)(F.ws + WS_WMUT), 512, 32 * nb, nullptr, scr, F.lane); continue; } r -= I_MU;
        if (r < I_DU) { const int kb = r / 32, nb = r % 32; cvt_item(F.in[I_WDU], 1024, 32 * nb, 64 * kb, (bf16*)(F.ws + WS_WDUT), 512, 32 * nb, nullptr, scr, F.lane); continue; } r -= I_DU;
        if (r < I_OUT) { const int kb = r / 32, nb = r % 32; cvt_item(F.in[I_WOUT], 1024, 32 * nb, 64 * kb, (bf16*)(F.ws + WS_WOUTT), 1024, 32 * nb, nullptr, scr, F.lane); continue; } r -= I_OUT;
        if (r < I_UQ) { const int kb = r / 24, nb = r % 24; cvt_item(F.in[I_WUQ], 768, 32 * nb, 64 * kb, (bf16*)(F.ws + WS_WUQT), 256, 32 * nb, F.in[I_QLN], scr, F.lane); continue; } r -= I_UQ;
        { const int kb = r / 32, nb = r % 32; cvt_item(F.in[I_WUKV], 1024, 32 * nb, 64 * kb, (bf16*)(F.ws + WS_WUKVT), 128, 32 * nb, F.in[I_KVLN], scr, F.lane); }
    }
}

__device__ __forceinline__ void p1_naive(const Frame& F) {
    const bf16* XN = (const bf16*)(F.ws + WS_XN); const float* W = F.in[I_WIN];
    for (long i = GTID; i < (long)NTOK * 4096; i += GSZ) {
        const int tok = (int)(i >> 12), c = (int)(i & 4095), src = win_src_col(c);
        float acc = 0.f;
        if (src >= 0) { const bf16* xr = XN + (size_t)tok * DM;
            for (int k = 0; k < DM; ++k) acc += bf2f(xr[k]) * bfr(W[(size_t)k * INW + src]); }
        const int pn = c >> 8;
        if (pn < 8) { bf16* base = (bf16*)(F.ws + WS_LAT + (size_t)(pn >> 1) * 16 * MiB); base[(size_t)tok * 512 + (pn & 1) * 256 + (c & 255)] = (bf16)f2bf(acc); }
        else { bf16* base = (bf16*)(F.ws + WS_GM + (size_t)((pn - 8) >> 2) * 32 * MiB); const float sg = 1.0f / (1.0f + expf(-acc));
            base[(size_t)tok * 1024 + ((pn - 8) & 3) * 256 + (c & 255)] = (bf16)f2bf(sg); }
    }
}

__device__ __forceinline__ size_t km_index(int b, int h, int s, int d) { return ((((size_t)(b * 8 + h) * 64 + (s >> 6)) * 12 + (d >> 3)) * 64 + (s & 63)) * 8 + (d & 7); }
__device__ __forceinline__ size_t kd_index(int b, int hs, int s, int d) { return ((((size_t)(b * 8 + hs) * 64 + (s >> 6)) * 8 + (d >> 3)) * 64 + (s & 63)) * 8 + (d & 7); }
__device__ __forceinline__ float p2_dotq(const bf16* lat, const float* g, const float* W, int col) {
    float a = 0.f; for (int k = 0; k < 256; ++k) a += bf2f(lat[k]) * bfr(g[k] * W[(size_t)k * 768 + col]); return a; }
__device__ __forceinline__ float p2_dotkv(const bf16* lat, const float* g, const float* W, int col) {
    float a = 0.f; for (int k = 0; k < 128; ++k) a += bf2f(lat[k]) * bfr(g[k] * W[(size_t)k * 1024 + col]); return a; }
__device__ __forceinline__ void p2_naive(const Frame& F) {
    const bf16* LAT = (const bf16*)(F.ws + WS_LAT);
    const float* cosm = (const float*)(F.ws + WS_TAB + TB_COSM); const float* sinm = (const float*)(F.ws + WS_TAB + TB_SINM);
    const float* cosd = (const float*)(F.ws + WS_TAB + TB_COSD); const float* sind = (const float*)(F.ws + WS_TAB + TB_SIND);
    bf16* QM = (bf16*)(F.ws + WS_QM); bf16* KM = (bf16*)(F.ws + WS_KM); bf16* VM = (bf16*)(F.ws + WS_VM);
    for (long i = GTID; i < (long)NTOK * 8; i += GSZ) {
        const int tok = (int)(i >> 3), h = (int)(i & 7), pos = tok & (SEQ - 1);
        const bf16* lat = LAT + (size_t)tok * 512; const float* g = F.in[I_QLN]; const float* W = F.in[I_WUQ]; const float* qg = F.in[I_QG];
        float sl = 0.f; for (int k = 0; k < 256; ++k) { const float v = bf2f(lat[k]); sl += v * v; }
        const float rs = 1.0f / sqrtf(sl * (1.f / 256.f) + EPS);
        float ss = 0.f; for (int d = 0; d < 96; ++d) { const float v = rs * p2_dotq(lat, g, W, h * 96 + d); ss += v * v; }
        const float rn = 1.0f / sqrtf(ss * (1.f / 96.f) + EPS);
        bf16* o = QM + ((size_t)tok * 8 + h) * 96;
        for (int d = 0; d < 64; ++d) o[d] = (bf16)f2bf(rs * p2_dotq(lat, g, W, h * 96 + d) * rn * qg[d] * QS_MLA);
        for (int f = 0; f < 16; ++f) {
            const float v1 = rs * p2_dotq(lat, g, W, h * 96 + 64 + f) * rn * qg[64 + f], v2 = rs * p2_dotq(lat, g, W, h * 96 + 80 + f) * rn * qg[80 + f];
            const float c = cosm[pos * 16 + f], s = sinm[pos * 16 + f];
            o[64 + f] = (bf16)f2bf((v1 * c - v2 * s) * QS_MLA); o[80 + f] = (bf16)f2bf((v2 * c + v1 * s) * QS_MLA); }
    }
    for (long i = GTID; i < (long)NTOK * 8; i += GSZ) {
        const int tok = (int)(i >> 3), h = (int)(i & 7), pos = tok & (SEQ - 1), b = tok >> 12;
        const bf16* lat = LAT + (size_t)tok * 512 + 256; const bf16* kr = LAT + (size_t)tok * 512 + 384;
        const float* g = F.in[I_KVLN]; const float* W = F.in[I_WUKV]; const float* kg = F.in[I_KG];
        float sl = 0.f; for (int k = 0; k < 128; ++k) { const float v = bf2f(lat[k]); sl += v * v; }
        const float rs = 1.0f / sqrtf(sl * (1.f / 128.f) + EPS);
        float ss = 0.f; for (int d = 0; d < 64; ++d) { const float v = rs * p2_dotkv(lat, g, W, h * 128 + d); ss += v * v; }
        for (int d = 0; d < 32; ++d) { const float v = bf2f(kr[d]); ss += v * v; }
        const float rn = 1.0f / sqrtf(ss * (1.f / 96.f) + EPS);
        for (int d = 0; d < 64; ++d) KM[km_index(b, h, pos, d)] = (bf16)f2bf(rs * p2_dotkv(lat, g, W, h * 128 + d) * rn * kg[d]);
        for (int f = 0; f < 16; ++f) {
            const float v1 = bf2f(kr[f]) * rn * kg[64 + f], v2 = bf2f(kr[16 + f]) * rn * kg[80 + f];
            const float c = cosm[pos * 16 + f], s = sinm[pos * 16 + f];
            KM[km_index(b, h, pos, 64 + f)] = (bf16)f2bf(v1 * c - v2 * s); KM[km_index(b, h, pos, 80 + f)] = (bf16)f2bf(v2 * c + v1 * s); }
        bf16* vo = VM + ((size_t)(b * 8 + h) * SEQ + pos) * 64;
        for (int d = 0; d < 64; ++d) vo[d] = (bf16)f2bf(rs * p2_dotkv(lat, g, W, h * 128 + 64 + d));
    }
    bf16* DQ = (bf16*)(F.ws + WS_DQ); const bf16* DKR = (const bf16*)(F.ws + WS_DKR); bf16* KD = (bf16*)(F.ws + WS_KD);
    for (long i = GTID; i < (long)NTOK * 8; i += GSZ) {
        const int tok = (int)(i >> 3), hs = (int)(i & 7), pos = tok & (SEQ - 1), b = tok >> 12;
        {   bf16* q = DQ + (size_t)tok * 512 + hs * 64; const float* g = F.in[I_DQG];
            float ss = 0.f; for (int d = 0; d < 64; ++d) { const float v = bf2f(q[d]); ss += v * v; }
            const float rn = 1.0f / sqrtf(ss * (1.f / 64.f) + EPS);
            for (int f = 0; f < 8; ++f) { const float v1 = bf2f(q[f]) * rn * g[f], v2 = bf2f(q[8 + f]) * rn * g[8 + f];
                const float c = cosd[pos * 8 + f], s = sind[pos * 8 + f];
                q[f] = (bf16)f2bf((v1 * c - v2 * s) * QS_DIFF); q[8 + f] = (bf16)f2bf((v2 * c + v1 * s) * QS_DIFF); }
            for (int d = 16; d < 64; ++d) q[d] = (bf16)f2bf(bf2f(q[d]) * rn * g[d] * QS_DIFF); }
        {   const bf16* k = DKR + (size_t)tok * 512 + hs * 64; const float* g = F.in[I_DKG];
            float ss = 0.f; for (int d = 0; d < 64; ++d) { const float v = bf2f(k[d]); ss += v * v; }
            const float rn = 1.0f / sqrtf(ss * (1.f / 64.f) + EPS);
            for (int f = 0; f < 8; ++f) { const float v1 = bf2f(k[f]) * rn * g[f], v2 = bf2f(k[8 + f]) * rn * g[8 + f];
                const float c = cosd[pos * 8 + f], s = sind[pos * 8 + f];
                KD[kd_index(b, hs, pos, f)] = (bf16)f2bf(v1 * c - v2 * s); KD[kd_index(b, hs, pos, 8 + f)] = (bf16)f2bf(v2 * c + v1 * s); }
            for (int d = 16; d < 64; ++d) KD[kd_index(b, hs, pos, d)] = (bf16)f2bf(bf2f(k[d]) * rn * g[d]); }
    }
}

__device__ __forceinline__ void p3_naive(const Frame& F, int only_kind = -1) {
    volatile LAS float* qs = (volatile LAS float*)(F.lds + F.wave * 1024);
    volatile LAS float* ps = qs + 128;
    const bf16* QM = (const bf16*)(F.ws + WS_QM); const bf16* KM = (const bf16*)(F.ws + WS_KM); const bf16* VM = (const bf16*)(F.ws + WS_VM);
    const bf16* QD = (const bf16*)(F.ws + WS_DQ); const bf16* KD = (const bf16*)(F.ws + WS_KD); const bf16* DV = (const bf16*)(F.ws + WS_DV);
    bf16* OM = (bf16*)(F.ws + WS_OM); bf16* OD = (bf16*)(F.ws + WS_OD);
    const int lane = F.lane;
    for (long task = GW; task < 2L * NTOK * 8; task += NGW) {
        const int kind = (int)(task / ((long)NTOK * 8)); const int r = (int)(task % ((long)NTOK * 8));
        if (only_kind >= 0 && kind != only_kind) continue;
        const int tok = r >> 3, hh = r & 7, b = tok >> 12, s = tok & (SEQ - 1);
        const int DQK = kind == 0 ? 96 : 64, NCH = DQK / 8;
        const bf16* q = kind == 0 ? QM + ((size_t)tok * 8 + hh) * 96 : QD + ((size_t)tok * 8 + hh) * 64;
        __builtin_amdgcn_wave_barrier();
        for (int d = lane; d < DQK; d += 64) qs[d] = bf2f(q[d]);
        __builtin_amdgcn_wave_barrier();
        const int ntile = (s >> 6) + 1;
        float m = -1e30f, l = 0.f, o0 = 0.f, o1 = 0.f;
        for (int t = 0; t < ntile; ++t) {
            const bf16* Kb = kind == 0 ? KM + ((size_t)(b * 8 + hh) * 64 + t) * 12 * 512 : KD + ((size_t)(b * 8 + hh) * 64 + t) * 8 * 512;
            float sc = 0.f;
            for (int c = 0; c < NCH; ++c) { const v4u kk = *(const GAS v4u*)(Kb + c * 512 + lane * 8);
                sc += qs[8 * c + 0] * bf2f(kk.x) + qs[8 * c + 1] * bf2f(kk.x >> 16) + qs[8 * c + 2] * bf2f(kk.y) + qs[8 * c + 3] * bf2f(kk.y >> 16)
                    + qs[8 * c + 4] * bf2f(kk.z) + qs[8 * c + 5] * bf2f(kk.z >> 16) + qs[8 * c + 6] * bf2f(kk.w) + qs[8 * c + 7] * bf2f(kk.w >> 16); }
            const float mn = fmaxf(m, wave_max(sc)); const float alpha = exp2f(m - mn); const float p = exp2f(sc - mn);
            __builtin_amdgcn_wave_barrier(); ps[lane] = p; __builtin_amdgcn_wave_barrier();
            l = l * alpha + wave_sum(p); o0 *= alpha; o1 *= alpha; m = mn;
            if (kind == 0) { const bf16* vb = VM + ((size_t)(b * 8 + hh) * SEQ + t * 64) * 64 + lane;
                for (int j = 0; j < 64; ++j) o0 += ps[j] * bf2f(vb[(size_t)j * 64]); }
            else { const bf16* vb = DV + ((size_t)(b * SEQ + t * 64)) * 512 + (hh >> 1) * 128 + lane;
                for (int j = 0; j < 64; ++j) { const float pj = ps[j]; o0 += pj * bf2f(vb[(size_t)j * 512]); o1 += pj * bf2f(vb[(size_t)j * 512 + 64]); } }
        }
        const float il = 1.0f / l;
        if (kind == 0) OM[(size_t)tok * 512 + hh * 64 + lane] = (bf16)f2bf(o0 * il);
        else { bf16* o = OD + ((size_t)tok * 8 + hh) * 128; o[lane] = (bf16)f2bf(o0 * il); o[lane + 64] = (bf16)f2bf(o1 * il); }
    }
}

__device__ __forceinline__ void p3b_combine(const Frame& F) {
    const bf16* OD = (const bf16*)(F.ws + WS_OD); bf16* ODN = (bf16*)(F.ws + WS_ODN);
    const float lam = *(const float*)(F.ws + WS_TAB + TB_LAM);
    const int h = F.lane >> 4, c = F.lane & 15;
    float g[8];
#pragma unroll
    for (int j = 0; j < 8; ++j) g[j] = F.in[I_SUBLN][c * 8 + j] * (1.0f - LAMBDA_INIT);
    for (int tok = GW; tok < NTOK; tok += NGW) {
        const v4u a = *(const GAS v4u*)(OD + ((size_t)tok * 8 + 2 * h) * 128 + c * 8);
        const v4u b = *(const GAS v4u*)(OD + ((size_t)tok * 8 + 2 * h + 1) * 128 + c * 8);
        float o[8];
        o[0] = bf2f(a.x) - lam * bf2f(b.x); o[1] = bf2f(a.x >> 16) - lam * bf2f(b.x >> 16);
        o[2] = bf2f(a.y) - lam * bf2f(b.y); o[3] = bf2f(a.y >> 16) - lam * bf2f(b.y >> 16);
        o[4] = bf2f(a.z) - lam * bf2f(b.z); o[5] = bf2f(a.z >> 16) - lam * bf2f(b.z >> 16);
        o[6] = bf2f(a.w) - lam * bf2f(b.w); o[7] = bf2f(a.w >> 16) - lam * bf2f(b.w >> 16);
        float ss = 0.f;
#pragma unroll
        for (int j = 0; j < 8; ++j) ss += o[j] * o[j];
        ss += __shfl_xor(ss, 1); ss += __shfl_xor(ss, 2); ss += __shfl_xor(ss, 4); ss += __shfl_xor(ss, 8);
        const float rn = 1.0f / sqrtf(ss * (1.f / 128.f) + EPS);
        v4u w; w.x = pk2(o[0] * rn * g[0], o[1] * rn * g[1]); w.y = pk2(o[2] * rn * g[2], o[3] * rn * g[3]);
        w.z = pk2(o[4] * rn * g[4], o[5] * rn * g[5]); w.w = pk2(o[6] * rn * g[6], o[7] * rn * g[7]);
        *(GAS v4u*)(ODN + (size_t)tok * 512 + h * 128 + c * 8) = w;
    }
}

__device__ __forceinline__ void p4_naive(const Frame& F) {
    const bf16* OM = (const bf16*)(F.ws + WS_OM); const bf16* ODN = (const bf16*)(F.ws + WS_ODN);
    const bf16* GM = (const bf16*)(F.ws + WS_GM); const bf16* GD = (const bf16*)(F.ws + WS_GD); bf16* MG = (bf16*)(F.ws + WS_MG);
    const float* Wm = F.in[I_WMU]; const float* Wd = F.in[I_WDU];
    for (long i = GTID; i < (long)NTOK * 1024; i += GSZ) {
        const int tok = (int)(i >> 10), n = (int)(i & 1023);
        float um = 0.f, ud = 0.f;
        for (int k = 0; k < 512; ++k) { um += bf2f(OM[(size_t)tok * 512 + k]) * bfr(Wm[(size_t)k * 1024 + n]); ud += bf2f(ODN[(size_t)tok * 512 + k]) * bfr(Wd[(size_t)k * 1024 + n]); }
        MG[i] = (bf16)f2bf(bf2f(GM[i]) * um + bf2f(GD[i]) * ud);
    }
}
__device__ __forceinline__ void p5_naive(const Frame& F) {
    const bf16* MG = (const bf16*)(F.ws + WS_MG); const float* W = F.in[I_WOUT];
    for (long i = GTID; i < (long)NTOK * 1024; i += GSZ) {
        const int tok = (int)(i >> 10), n = (int)(i & 1023);
        float a = 0.f; for (int k = 0; k < 1024; ++k) a += bf2f(MG[(size_t)tok * 1024 + k]) * bfr(W[(size_t)k * 1024 + n]);
        F.out[i] = F.in[I_X][i] + a;
    }
}

__device__ __forceinline__ void p6_router(const Frame& F) {
    bf16* H2 = (bf16*)(F.ws + WS_XN);
    int* toke = (int*)(F.ws + WS_TAB + TB_TOKE); float* tokw = (float*)(F.ws + WS_TAB + TB_TOKW);
    const float* wrg = F.in[I_WRG]; const float* wre = F.in[I_WRE];
    for (int tok = GW; tok < NTOK; tok += NGW) {
        const GAS f32x4* xr = (const GAS f32x4*)(F.out + (size_t)tok * DM) + F.lane;
        const GAS f32x4* gr = (const GAS f32x4*)F.in[I_NFFN] + F.lane;
        float s = 0.f;
#pragma unroll
        for (int j = 0; j < 4; ++j) { const f32x4 v = xr[64 * j]; s += (v.x * v.x + v.y * v.y) + (v.z * v.z + v.w * v.w); }
        const float rs = 1.0f / sqrtf(wave_sum(s) * (1.f / DM) + EPS);
        GAS unsigned long long* o8 = (GAS unsigned long long*)(H2 + (size_t)tok * DM) + F.lane;
        float acc[36];
#pragma unroll
        for (int n = 0; n < 36; ++n) acc[n] = 0.f;
#pragma unroll 1
        for (int j = 0; j < 4; ++j) { const f32x4 v = xr[64 * j]; const f32x4 g = gr[64 * j]; f32x4 h; h.x = v.x * rs * g.x; h.y = v.y * rs * g.y; h.z = v.z * rs * g.z; h.w = v.w * rs * g.w;
            o8[64 * j] = (unsigned long long)pk2(h.x, h.y) | ((unsigned long long)pk2(h.z, h.w) << 32);
            const int kb = 4 * F.lane + 256 * j;
#pragma unroll
            for (int e = 0; e < 4; ++e) { const float hk = h[e];
                const f32x4 wg = *(const GAS f32x4*)(wrg + (size_t)(kb + e) * 4);
                acc[0] += hk * wg.x; acc[1] += hk * wg.y; acc[2] += hk * wg.z; acc[3] += hk * wg.w;
#pragma unroll
                for (int q = 0; q < 8; ++q) { const f32x4 we = *(const GAS f32x4*)(wre + (size_t)(kb + e) * 32 + 4 * q);
                    acc[4 + 4 * q] += hk * we.x; acc[5 + 4 * q] += hk * we.y; acc[6 + 4 * q] += hk * we.z; acc[7 + 4 * q] += hk * we.w; }
                asm volatile("" ::: "memory"); } }
#pragma unroll
        for (int n = 0; n < 36; ++n) acc[n] = wave_sum(acc[n]);
        float gl[4];
#pragma unroll
        for (int n = 0; n < 4; ++n) gl[n] = acc[n] + F.in[I_BRG][n];
        int g = 0; float gm = gl[0];
#pragma unroll
        for (int n = 1; n < 4; ++n) if (gl[n] > gm) { gm = gl[n]; g = n; }
        float gsum = 0.f;
#pragma unroll
        for (int n = 0; n < 4; ++n) gsum += expf(gl[n] - gm);
        const float pg = 1.0f / gsum;
        float el[8];
#pragma unroll
        for (int n = 0; n < 8; ++n) el[n] = (g == 0 ? acc[4 + n] : g == 1 ? acc[12 + n] : g == 2 ? acc[20 + n] : acc[28 + n]) + F.in[I_BRE][8 * g + n];
        int i1 = 0; float l1 = el[0];
#pragma unroll
        for (int n = 1; n < 8; ++n) if (el[n] > l1) { l1 = el[n]; i1 = n; }
        int i2 = -1; float l2 = -3.0e38f;
#pragma unroll
        for (int n = 0; n < 8; ++n) if (n != i1 && el[n] > l2) { l2 = el[n]; i2 = n; }
        const float p2 = expf(l2 - l1); const float w1 = pg / (1.0f + p2), w2 = pg * p2 / (1.0f + p2);
        if (F.lane == 0) { const int e1 = 8 * g + i1, e2 = 8 * g + i2; toke[2 * tok] = e1; toke[2 * tok + 1] = e2; tokw[2 * tok] = w1; tokw[2 * tok + 1] = w2;
            int* list = (int*)(F.ws + WS_LIST); unsigned* cnt = (unsigned*)(F.ctl + CW_CNT);
            const unsigned p1 = __hip_atomic_fetch_add(cnt + e1, 1u, __ATOMIC_RELAXED, __HIP_MEMORY_SCOPE_AGENT); list[e1 * NTOK + p1] = 2 * tok;
            const unsigned p2b = __hip_atomic_fetch_add(cnt + e2, 1u, __ATOMIC_RELAXED, __HIP_MEMORY_SCOPE_AGENT); list[e2 * NTOK + p2b] = 2 * tok + 1; }
    }
}
__device__ __forceinline__ void p6_expert_weights(const Frame& F) {
    LAS float* scr = (LAS float*)(F.lds + F.wave * 16384);
    for (int it = GW; it < 8192 + 4096; it += NGW) {
        if (it < 8192) { const int e = it >> 8, r = it & 255, kb = r >> 4, nb = r & 15, ct = nb >> 3, half = (nb >> 2) & 1, j0 = 32 * (nb & 3);
            const float* W = (half ? F.in[I_WEU] : F.in[I_WEG]) + (size_t)e * 1024 * 256;
            cvt_item(W, 256, 128 * ct + j0, 64 * kb, (bf16*)(F.ws + WS_WGUT) + (size_t)e * 512 * 1024, 1024, 32 * nb, nullptr, scr, F.lane); }
        else { const int r0 = it - 8192, e = r0 >> 7, r = r0 & 127, kb = r >> 5, nb = r & 31;
            cvt_item(F.in[I_WED] + (size_t)e * 256 * 1024, 1024, 32 * nb, 64 * kb, (bf16*)(F.ws + WS_WDT) + (size_t)e * 1024 * 256, 256, 32 * nb, nullptr, scr, F.lane); }
    }
}

__device__ __forceinline__ void p7a_naive(const Frame& F) {
    const bf16* H2 = (const bf16*)(F.ws + WS_XN); bf16* HN = (bf16*)(F.ws + WS_H2N); const int* toke = (const int*)(F.ws + WS_TAB + TB_TOKE);
    for (long i = GTID; i < (long)NTOK * 2 * 256; i += GSZ) {
        const int ts = (int)(i >> 8), j = (int)(i & 255), tok = ts >> 1, e = toke[ts];
        const float* Wg = F.in[I_WEG] + (size_t)e * 1024 * 256; const float* Wu = F.in[I_WEU] + (size_t)e * 1024 * 256;
        float g = 0.f, u = 0.f;
        for (int k = 0; k < 1024; ++k) { const float h = bf2f(H2[(size_t)tok * 1024 + k]); g += h * bfr(Wg[(size_t)k * 256 + j]); u += h * bfr(Wu[(size_t)k * 256 + j]); }
        HN[i] = (bf16)f2bf(g / (1.0f + expf(-g)) * u);
    }
}
__device__ __forceinline__ void p7b_naive(const Frame& F) {
    const bf16* HN = (const bf16*)(F.ws + WS_H2N); bf16* Y = (bf16*)(F.ws + WS_Y);
    const int* toke = (const int*)(F.ws + WS_TAB + TB_TOKE); const float* tokw = (const float*)(F.ws + WS_TAB + TB_TOKW);
    for (long i = GTID; i < (long)NTOK * 2 * 1024; i += GSZ) {
        const int ts = (int)(i >> 10), n = (int)(i & 1023), tok = ts >> 1, slot = ts & 1, e = toke[ts];
        const float* Wd = F.in[I_WED] + (size_t)e * 256 * 1024;
        float a = 0.f; for (int k = 0; k < 256; ++k) a += bf2f(HN[(size_t)ts * 256 + k]) * bfr(Wd[(size_t)k * 1024 + n]);
        Y[((size_t)slot * NTOK + tok) * 1024 + n] = (bf16)f2bf(tokw[ts] * a);
    }
}
__device__ __forceinline__ void p8_final(const Frame& F) {
    const bf16* Y = (const bf16*)(F.ws + WS_Y);
    for (long i = GTID; i < (long)NTOK * 256; i += GSZ) {
        const f32x4 x = *(const GAS f32x4*)(F.out + 4 * i);
        const v2u a = *(const GAS v2u*)(Y + 4 * i), b = *(const GAS v2u*)(Y + (size_t)NTOK * 1024 + 4 * i);
        f32x4 o; o.x = x.x + bf2f(a.x) + bf2f(b.x); o.y = x.y + bf2f(a.x >> 16) + bf2f(b.x >> 16);
        o.z = x.z + bf2f(a.y) + bf2f(b.y); o.w = x.w + bf2f(a.y >> 16) + bf2f(b.y >> 16);
        *(GAS f32x4*)(F.out + 4 * i) = o;
    }
}


namespace pg8 {
#define PG8_LAS __attribute__((address_space(3)))
typedef unsigned short bf16_t;
typedef short bf16x8 __attribute__((ext_vector_type(8)));
typedef float f32x4 __attribute__((ext_vector_type(4)));
typedef unsigned u32x4 __attribute__((ext_vector_type(4)));
constexpr int BM = 256, BK = 64, HALF = 128, HTB = HALF * BK * 2, STAGE_BYTES = 8 * HTB, NXCD = 8, WGM = 8;
__host__ __device__ __forceinline__ int lds_byte(int r, int c) { const int st = (r >> 4) * 2 + (c >> 5), rr = r & 15, cc = c & 31, ob = rr * 64 + cc * 2; return st * 1024 + (ob ^ (((ob >> 9) & 1) << 5)); }
__host__ __device__ __forceinline__ void stage_rc(int b, int& R, int& C) { const int st = b / 1024, sb = b % 1024, swz = sb ^ (((sb >> 9) & 1) << 5); R = (st >> 1) * 16 + swz / 64; C = (st & 1) * 32 + (swz % 64) / 2; }
__host__ __device__ __forceinline__ int perm32(int rho) { const int n = rho >> 4, i = rho & 15; return 8 * (i >> 2) + 4 * n + (i & 3); }
struct Unit { int pm, pn, aux; };
struct StaticOrder {
    int nM, nN, nwg, G, c;
    __host__ __device__ void init(int M, int N, int G_, int c_) { nM = M / BM; nN = N / BM; nwg = nM * nN; G = G_; c = c_; }
    __host__ __device__ bool next(int i, Unit& u) const {
        const long L = (long)i * G + c; if (L >= nwg) return false;
        int wgid = (int)L; { const int q = nwg / NXCD, r = nwg % NXCD, xcd = wgid % NXCD, off = wgid / NXCD; wgid = (xcd < r ? xcd * (q + 1) : r * (q + 1) + (xcd - r) * q) + off; }
        const int nig = WGM * nN, gid = wgid / nig, fm = gid * WGM, gsz = (nM - fm) < WGM ? (nM - fm) : WGM;
        u.pm = fm + ((wgid % nig) % gsz); u.pn = (wgid % nig) / gsz; u.aux = 0; return true;
    }
};
struct PlainSched { StaticOrder so; const char* A; const char* Bt; size_t tstep;
    __device__ __forceinline__ bool next(int i, Unit& u) const { return so.next(i, u); }
    __device__ __forceinline__ const char* a_tile(const Unit& u) const { return A + (size_t)u.pm * tstep; }
    __device__ __forceinline__ const char* b_tile(const Unit& u) const { return Bt + (size_t)u.pn * tstep; }
};
__device__ __forceinline__ unsigned cvt_pk_bf16(float lo, float hi) { unsigned r; asm volatile("v_cvt_pk_bf16_f32 %0, %1, %2" : "=v"(r) : "v"(lo), "v"(hi)); return r; }

template <class Epi, class Sched, bool ALIGN_EPI = false, bool SP2 = false, bool GATHER = false>
__device__ __forceinline__ void gemm_phase(PG8_LAS unsigned char* lds, const int K, const Sched& S, const Epi& E) {
    const int tid = threadIdx.x, wid = __builtin_amdgcn_readfirstlane(tid >> 6), lane = tid & 63, wr = wid >> 2, wc = wid & 3, fr = lane & 15, fq = lane >> 4;
    const int nt = K / BK;
    unsigned voffA[2][2], nvoffA[2][2], voffB[2]; int stR[2], stC[2];
    const size_t kstep = (size_t)(BK * 2);
    const size_t hstep = (size_t)HALF * K * 2;
#pragma unroll
    for (int i = 0; i < 2; ++i) { int R, C; stage_rc(tid * 16 + i * 8192, R, C); const int Rb = Epi::PERM ? ((R & ~31) + perm32(R & 31)) : R; stR[i] = R; stC[i] = C;
        voffA[0][i] = (unsigned)(R * K + C) * 2u; voffA[1][i] = voffA[0][i] + (unsigned)hstep; voffB[i] = (unsigned)(Rb * K + C) * 2u;
        nvoffA[0][i] = voffA[0][i]; nvoffA[1][i] = voffA[1][i]; }
    const unsigned ldsw = (unsigned)wid * 1024u;
    const int aoff = lds_byte(wr * 64 + fr, fq * 8), boff = lds_byte(wc * 32 + fr, fq * 8);
#define PG8_SA(b, h) (((b) * 2 + (h)) * HTB)
#define PG8_SB(b, h) ((4 + (b) * 2 + (h)) * HTB)
#define PG8_STAGE(bufoff, gbase, voff) do { _Pragma("unroll") for (int _i = 0; _i < 2; ++_i) \
        __builtin_amdgcn_global_load_lds((const unsigned*)((const char*)(gbase) + (voff)[_i]), (PG8_LAS unsigned*)(lds + (bufoff) + ldsw + _i * 8192), 16, 0, 0); } while (0)
#define PG8_LDA(dst, b, h) do { _Pragma("unroll") for (int m = 0; m < 4; ++m) _Pragma("unroll") for (int k = 0; k < 2; ++k) dst[m][k] = *(const PG8_LAS bf16x8*)(lds + PG8_SA(b, h) + aoff + m * 2048 + k * 1024); } while (0)
#define PG8_LDB(dst, b, h) do { _Pragma("unroll") for (int n = 0; n < 2; ++n) _Pragma("unroll") for (int k = 0; k < 2; ++k) dst[n][k] = *(const PG8_LAS bf16x8*)(lds + PG8_SB(b, h) + boff + n * 2048 + k * 1024); } while (0)
#define PG8_MMA(ai, bj, At, Bt) do { __builtin_amdgcn_s_setprio(1); _Pragma("unroll") for (int m = 0; m < 4; ++m) _Pragma("unroll") for (int n = 0; n < 2; ++n) _Pragma("unroll") for (int k = 0; k < 2; ++k) \
        acc[ai][bj][m][n] = __builtin_amdgcn_mfma_f32_16x16x32_bf16(Bt[n][k], At[m][k], acc[ai][bj][m][n], 0, 0, 0); __builtin_amdgcn_s_setprio(0); } while (0)
#define PG8_WAIT_V(n) asm volatile("s_waitcnt vmcnt(" #n ")" ::: "memory")
#define PG8_WAIT_L(n) asm volatile("s_waitcnt lgkmcnt(" #n ")" ::: "memory")
#define PG8_BAR __builtin_amdgcn_s_barrier()
#define PG8_SCHED __builtin_amdgcn_sched_barrier(0)
    Unit cur, nxt; int ui = 0;
    if (!S.next(0, cur)) return;
    f32x4 acc[2][2][4][2];
#pragma unroll
    for (int a = 0; a < 2; ++a)
#pragma unroll
        for (int b = 0; b < 2; ++b)
#pragma unroll
            for (int m = 0; m < 4; ++m)
#pragma unroll
                for (int n = 0; n < 2; ++n) acc[a][b][m][n] = (f32x4){0.f, 0.f, 0.f, 0.f};
    bf16x8 At[4][2], B0[2][2], B1[2][2];
    const char* cA = S.a_tile(cur); const char* cB = S.b_tile(cur);
    if constexpr (GATHER) {
#pragma unroll
        for (int h = 0; h < 2; ++h)
#pragma unroll
            for (int i = 0; i < 2; ++i) voffA[h][i] = S.a_voff(cur, h * HALF + stR[i]) + (unsigned)stC[i] * 2u; }
    if constexpr (SP2) {
        PG8_STAGE(PG8_SB(0, 0), cB, voffB); PG8_STAGE(PG8_SB(0, 1), cB + hstep, voffB); PG8_STAGE(PG8_SA(0, 0), cA, voffA[0]); PG8_STAGE(PG8_SA(0, 1), cA, voffA[1]);
        if (wr == 1) PG8_BAR;
        PG8_WAIT_V(2); PG8_BAR;
        PG8_STAGE(PG8_SB(1, 0), cB + kstep, voffB); PG8_STAGE(PG8_SA(1, 0), cA + kstep, voffA[0]); PG8_STAGE(PG8_SB(1, 1), cB + hstep + kstep, voffB);
        PG8_WAIT_V(6); PG8_BAR;
    } else {
        PG8_STAGE(PG8_SB(0, 0), cB, voffB); PG8_STAGE(PG8_SA(0, 0), cA, voffA[0]); PG8_STAGE(PG8_SB(0, 1), cB + hstep, voffB); PG8_STAGE(PG8_SA(0, 1), cA, voffA[1]);
        if (wr == 1) PG8_BAR;
        PG8_WAIT_V(4); PG8_BAR;
        PG8_STAGE(PG8_SB(1, 0), cB + kstep, voffB); PG8_STAGE(PG8_SA(1, 0), cA + kstep, voffA[0]); PG8_STAGE(PG8_SB(1, 1), cB + hstep + kstep, voffB);
        PG8_WAIT_V(6); PG8_BAR;
    }
    for (;;) {
        const bool has_next = S.next(ui + 1, nxt);
        const char* nA = has_next ? S.a_tile(nxt) : cA; const char* nB = has_next ? S.b_tile(nxt) : cB;
        if constexpr (GATHER) { if (has_next) {
#pragma unroll
            for (int h = 0; h < 2; ++h)
#pragma unroll
                for (int i = 0; i < 2; ++i) nvoffA[h][i] = S.a_voff(nxt, h * HALF + stR[i]) + (unsigned)stC[i] * 2u; } }
        for (int t = 0; t < nt; t += 2) {
            const bool last = (t == nt - 2);
            const char* a1 = cA + (size_t)(t + 1) * kstep;
            const char* a2 = last ? nA : cA + (size_t)(t + 2) * kstep; const char* b2 = last ? nB : cB + (size_t)(t + 2) * kstep;
            const char* a3 = a2 + kstep; const char* b3 = b2 + kstep;
            unsigned va2[2][2];
#pragma unroll
            for (int h = 0; h < 2; ++h)
#pragma unroll
                for (int i = 0; i < 2; ++i) va2[h][i] = (GATHER && last) ? nvoffA[h][i] : voffA[h][i];
            if constexpr (SP2) {
            PG8_LDB(B0, 0, 0); PG8_LDB(B1, 0, 1); PG8_SCHED; PG8_LDA(At, 0, 0); PG8_STAGE(PG8_SA(1, 1), a1, voffA[1]);
            PG8_WAIT_V(8); PG8_WAIT_L(0); PG8_BAR; PG8_MMA(0, 0, At, B0); PG8_MMA(0, 1, At, B1); PG8_BAR; PG8_SCHED;
            PG8_LDA(At, 0, 1); PG8_STAGE(PG8_SB(0, 0), b2, voffB); PG8_STAGE(PG8_SB(0, 1), b2 + hstep, voffB); PG8_STAGE(PG8_SA(0, 0), a2, va2[0]);
            PG8_WAIT_V(8); PG8_WAIT_L(0); PG8_BAR; PG8_MMA(1, 0, At, B0); PG8_MMA(1, 1, At, B1); PG8_BAR; PG8_SCHED;
            PG8_LDB(B0, 1, 0); PG8_LDB(B1, 1, 1); PG8_SCHED; PG8_LDA(At, 1, 0); PG8_STAGE(PG8_SA(0, 1), a2, va2[1]);
            PG8_WAIT_V(8); PG8_WAIT_L(0); PG8_BAR; PG8_MMA(0, 0, At, B0); PG8_MMA(0, 1, At, B1); PG8_BAR; PG8_SCHED;
            PG8_LDA(At, 1, 1); PG8_STAGE(PG8_SB(1, 0), b3, voffB); PG8_STAGE(PG8_SB(1, 1), b3 + hstep, voffB); PG8_STAGE(PG8_SA(1, 0), a3, va2[0]);
            PG8_WAIT_V(8); PG8_WAIT_L(0); PG8_BAR; PG8_MMA(1, 0, At, B0); PG8_MMA(1, 1, At, B1); PG8_BAR; PG8_SCHED;
            } else {
            PG8_LDB(B0, 0, 0); PG8_SCHED; PG8_LDA(At, 0, 0); PG8_STAGE(PG8_SA(1, 1), a1, voffA[1]);
            PG8_WAIT_L(8); PG8_BAR; PG8_WAIT_L(0); PG8_MMA(0, 0, At, B0); PG8_BAR; PG8_SCHED;
            PG8_LDB(B1, 0, 1); PG8_STAGE(PG8_SB(0, 0), b2, voffB);
            PG8_BAR; PG8_WAIT_L(0); PG8_MMA(0, 1, At, B1); PG8_BAR;
            PG8_LDA(At, 0, 1); PG8_STAGE(PG8_SA(0, 0), a2, va2[0]);
            PG8_BAR; PG8_WAIT_L(0); PG8_MMA(1, 0, At, B0); PG8_BAR; PG8_SCHED;
            PG8_STAGE(PG8_SB(0, 1), b2 + hstep, voffB);
            PG8_WAIT_V(6); PG8_BAR; PG8_MMA(1, 1, At, B1); PG8_BAR;
            PG8_LDB(B0, 1, 0); PG8_SCHED; PG8_LDA(At, 1, 0); PG8_STAGE(PG8_SA(0, 1), a2, va2[1]);
            PG8_WAIT_L(8); PG8_BAR; PG8_WAIT_L(0); PG8_MMA(0, 0, At, B0); PG8_BAR; PG8_SCHED;
            PG8_LDB(B1, 1, 1); PG8_STAGE(PG8_SB(1, 0), b3, voffB);
            PG8_BAR; PG8_WAIT_L(0); PG8_MMA(0, 1, At, B1); PG8_BAR;
            PG8_LDA(At, 1, 1); PG8_STAGE(PG8_SA(1, 0), a3, va2[0]);
            PG8_BAR; PG8_WAIT_L(0); PG8_MMA(1, 0, At, B0); PG8_BAR; PG8_SCHED;
            PG8_STAGE(PG8_SB(1, 1), b3 + hstep, voffB);
            PG8_WAIT_V(6); PG8_BAR; PG8_MMA(1, 1, At, B1); PG8_BAR;
            }
        }
        if constexpr (ALIGN_EPI) { if (wr == 0) PG8_BAR; }
        E(acc, cur, wr, wc, fr, fq);
        if (!has_next) break;
#pragma unroll
        for (int a = 0; a < 2; ++a)
#pragma unroll
            for (int b = 0; b < 2; ++b)
#pragma unroll
                for (int m = 0; m < 4; ++m)
#pragma unroll
                    for (int n = 0; n < 2; ++n) acc[a][b][m][n] = (f32x4){0.f, 0.f, 0.f, 0.f};
        cur = nxt; cA = nA; cB = nB; ++ui;
        if constexpr (GATHER) {
#pragma unroll
            for (int h = 0; h < 2; ++h)
#pragma unroll
                for (int i = 0; i < 2; ++i) voffA[h][i] = nvoffA[h][i]; }
        if constexpr (ALIGN_EPI) { if (wr == 1) PG8_BAR; }
    }
    PG8_WAIT_V(0);
    if constexpr (!ALIGN_EPI) { if (wr == 0) PG8_BAR; }
    PG8_BAR;
#undef PG8_SA
#undef PG8_SB
#undef PG8_STAGE
#undef PG8_LDA
#undef PG8_LDB
#undef PG8_MMA
#undef PG8_WAIT_V
#undef PG8_WAIT_L
#undef PG8_BAR
#undef PG8_SCHED
}
}

struct EpiP1 {
    static constexpr bool PERM = true;
    unsigned char* ws;
    __device__ __forceinline__ void operator()(const pg8::f32x4 (&acc)[2][2][4][2], const pg8::Unit& u, int wr, int wc, int fr, int fq) const {
        const int pn = u.pn; const bool gate = pn >= 8;
        bf16* base = gate ? (bf16*)(ws + WS_GM + (size_t)((pn - 8) >> 2) * 32 * MiB) : (bf16*)(ws + WS_LAT + (size_t)(pn >> 1) * 16 * MiB);
        const int ldc = gate ? 1024 : 512, coloff = gate ? ((pn - 8) & 3) * 256 : (pn & 1) * 256;
        const int row0 = u.pm * 256 + wr * 64 + fr, col0 = coloff + wc * 32 + 8 * fq;
#pragma unroll
        for (int ai = 0; ai < 2; ++ai)
#pragma unroll
            for (int m = 0; m < 4; ++m) { bf16* rowp = base + (size_t)(row0 + ai * 128 + m * 16) * ldc + col0;
#pragma unroll
                for (int bj = 0; bj < 2; ++bj) { pg8::f32x4 v0 = acc[ai][bj][m][0], v1 = acc[ai][bj][m][1];
                    if (gate) {
#pragma unroll
                        for (int e = 0; e < 4; ++e) { v0[e] = __builtin_amdgcn_rcpf(1.0f + __builtin_amdgcn_exp2f(-LOG2E * v0[e])); v1[e] = __builtin_amdgcn_rcpf(1.0f + __builtin_amdgcn_exp2f(-LOG2E * v1[e])); } }
                    pg8::u32x4 w; w.x = pg8::cvt_pk_bf16(v0[0], v0[1]); w.y = pg8::cvt_pk_bf16(v0[2], v0[3]); w.z = pg8::cvt_pk_bf16(v1[0], v1[1]); w.w = pg8::cvt_pk_bf16(v1[2], v1[3]);
                    *(pg8::u32x4*)(rowp + bj * 128) = w; } }
    }
};
struct P4Sched { pg8::StaticOrder so; const char *A0, *B0, *A1, *B1; size_t tstep;
    __device__ __forceinline__ bool next(int i, pg8::Unit& u) const { if (i >= 2) return false; if (!so.next(0, u)) return false; u.aux = i; return true; }
    __device__ __forceinline__ const char* a_tile(const pg8::Unit& u) const { return (u.aux ? A1 : A0) + (size_t)u.pm * tstep; }
    __device__ __forceinline__ const char* b_tile(const pg8::Unit& u) const { return (u.aux ? B1 : B0) + (size_t)u.pn * tstep; }
};
struct EpiP4 {
    static constexpr bool PERM = true;
    const bf16* GM; const bf16* GD; float* T; bf16* MG;
    __device__ __forceinline__ void operator()(const pg8::f32x4 (&acc)[2][2][4][2], const pg8::Unit& u, int wr, int wc, int fr, int fq) const {
        const int row0 = u.pm * 256 + wr * 64 + fr, col0 = u.pn * 256 + wc * 32 + 8 * fq; const bf16* G = u.aux ? GD : GM;
#pragma unroll
        for (int ai = 0; ai < 2; ++ai)
#pragma unroll
            for (int m = 0; m < 4; ++m)
#pragma unroll
                for (int bj = 0; bj < 2; ++bj) { const size_t idx = (size_t)(row0 + ai * 128 + m * 16) * 1024 + col0 + bj * 128;
                    const pg8::u32x4 g = *(const pg8::u32x4*)(G + idx);
                    pg8::f32x4 v0 = acc[ai][bj][m][0], v1 = acc[ai][bj][m][1];
                    v0[0] *= bf2f(g.x); v0[1] *= bf2f(g.x >> 16); v0[2] *= bf2f(g.y); v0[3] *= bf2f(g.y >> 16);
                    v1[0] *= bf2f(g.z); v1[1] *= bf2f(g.z >> 16); v1[2] *= bf2f(g.w); v1[3] *= bf2f(g.w >> 16);
                    if (u.aux == 0) { *(pg8::f32x4*)(T + idx) = v0; *(pg8::f32x4*)(T + idx + 4) = v1; }
                    else { v0 += *(const pg8::f32x4*)(T + idx); v1 += *(const pg8::f32x4*)(T + idx + 4);
                        pg8::u32x4 w; w.x = pg8::cvt_pk_bf16(v0[0], v0[1]); w.y = pg8::cvt_pk_bf16(v0[2], v0[3]); w.z = pg8::cvt_pk_bf16(v1[0], v1[1]); w.w = pg8::cvt_pk_bf16(v1[2], v1[3]);
                        *(pg8::u32x4*)(MG + idx) = w; }
                    asm volatile("" ::: "memory"); }
    }
};
struct EpiP5 {
    static constexpr bool PERM = false;
    const float* x; float* out;
    __device__ __forceinline__ void operator()(const pg8::f32x4 (&acc)[2][2][4][2], const pg8::Unit& u, int wr, int wc, int fr, int fq) const {
        const int row0 = u.pm * 256 + wr * 64 + fr, col0 = u.pn * 256 + wc * 32 + 4 * fq;
#pragma unroll
        for (int ai = 0; ai < 2; ++ai)
#pragma unroll
            for (int m = 0; m < 4; ++m)
#pragma unroll
                for (int bj = 0; bj < 2; ++bj)
#pragma unroll
                    for (int n = 0; n < 2; ++n) { const size_t idx = (size_t)(row0 + ai * 128 + m * 16) * 1024 + col0 + bj * 128 + n * 16;
                        *(pg8::f32x4*)(out + idx) = *(const pg8::f32x4*)(x + idx) + acc[ai][bj][m][n];
                        if (n == 1) asm volatile("" ::: "memory"); }
    }
};
__device__ __forceinline__ void p1_fast(const Frame& F) {
    pg8::PlainSched S; S.so.init(NTOK, 4096, F.G, (int)blockIdx.x); S.A = (const char*)(F.ws + WS_XN); S.Bt = (const char*)(F.ws + WS_WINT); S.tstep = (size_t)256 * 1024 * 2;
    EpiP1 E{F.ws};
    pg8::gemm_phase<EpiP1, pg8::PlainSched, true, true>(F.lds, 1024, S, E);
}
__device__ __forceinline__ void p4_fast(const Frame& F) {
    P4Sched S; S.so.init(NTOK, 1024, F.G, (int)blockIdx.x); S.tstep = (size_t)256 * 512 * 2;
    S.A0 = (const char*)(F.ws + WS_OM); S.B0 = (const char*)(F.ws + WS_WMUT); S.A1 = (const char*)(F.ws + WS_ODN); S.B1 = (const char*)(F.ws + WS_WDUT);
    EpiP4 E{(const bf16*)(F.ws + WS_GM), (const bf16*)(F.ws + WS_GD), (float*)(F.ws + WS_T), (bf16*)(F.ws + WS_MG)};
    pg8::gemm_phase<EpiP4, P4Sched, true, true>(F.lds, 512, S, E);
}
__device__ __forceinline__ void p5_fast(const Frame& F) {
    pg8::PlainSched S; S.so.init(NTOK, 1024, F.G, (int)blockIdx.x); S.A = (const char*)(F.ws + WS_MG); S.Bt = (const char*)(F.ws + WS_WOUTT); S.tstep = (size_t)256 * 1024 * 2;
    EpiP5 E{F.in[I_X], F.out};
    pg8::gemm_phase<EpiP5, pg8::PlainSched, false, true>(F.lds, 1024, S, E);
}


namespace att {
typedef short bf16x8 __attribute__((ext_vector_type(8)));
typedef short s16x4 __attribute__((ext_vector_type(4)));
typedef float f32x16 __attribute__((ext_vector_type(16)));
typedef float f32x4v __attribute__((ext_vector_type(4)));
#define ATT_MFMA(a, b, c) __builtin_amdgcn_mfma_f32_32x32x16_bf16(a, b, c, 0, 0, 0)
constexpr int KOFF = 0, VOFF = 24576, WSF = 57344, OST = 59392;
__device__ __forceinline__ void half_xchg(float& a, float& b) { asm volatile("s_nop 1\n\tv_permlane32_swap_b32 %0, %1\n\ts_nop 1" : "+v"(a), "+v"(b)); }
__device__ __forceinline__ float half_max(float v) { float a = v, b = v; half_xchg(a, b); return fmaxf(a, b); }
__device__ __forceinline__ float half_sum(float v) { float a = v, b = v; half_xchg(a, b); return a + b; }
__device__ __forceinline__ unsigned pkbf(float lo, float hi) { typedef float f2 __attribute__((ext_vector_type(2))); typedef __bf16 b2 __attribute__((ext_vector_type(2)));
    f2 v = {lo, hi}; b2 b = __builtin_convertvector(v, b2); return __builtin_bit_cast(unsigned, b); }
__device__ __forceinline__ bf16x8 pack8(const f32x16& p, int o) { v4u w; w.x = pkbf(p[o], p[o + 1]); w.y = pkbf(p[o + 2], p[o + 3]); w.z = pkbf(p[o + 4], p[o + 5]); w.w = pkbf(p[o + 6], p[o + 7]); return __builtin_bit_cast(bf16x8, w); }

template <int DQK, int DV>
__device__ __forceinline__ void attn_unit(LAS unsigned char* lds, const bf16* Q, int qstride, const bf16* Kt, const bf16* V, int vstride, bf16* O, int ostride, int qb) {
    constexpr int KSLOT = 64 * DQK * 2, VSLOT = 64 * DV * 2, NPK = DQK / 8, NPV = DV / 8, NKS = DQK / 16, NDB = DV / 32;
    const int lane = threadIdx.x & 63, wave = __builtin_amdgcn_readfirstlane(threadIdx.x >> 6), r32 = lane & 31, hi = lane >> 5;
    const int NTmax = 4 * qb + 4, NTw = 4 * qb + (wave >> 1) + 1;
    volatile LAS float* wsf = (volatile LAS float*)(lds + WSF + wave * 256);
#define ATT_DMA(t, sl) do { \
        _Pragma("unroll") for (int p = wave; p < NPK; p += 8) \
            __builtin_amdgcn_global_load_lds((const unsigned*)(Kt + (size_t)(t) * 64 * DQK + p * 512 + lane * 8), (LAS unsigned*)(lds + KOFF + (sl) * KSLOT + p * 1024), 16, 0, 0); \
        _Pragma("unroll") for (int p = wave; p < NPV; p += 8) \
            __builtin_amdgcn_global_load_lds((const unsigned*)(V + (size_t)((t) * 64 + 16 * (p & 3) + (lane >> 2)) * vstride + 32 * (p >> 2) + 8 * (lane & 3)), (LAS unsigned*)(lds + VOFF + (sl) * VSLOT + p * 1024), 16, 0, 0); \
    } while (0)
#define ATT_WAITBAR() asm volatile("s_waitcnt vmcnt(0) lgkmcnt(0)\n\ts_barrier" ::: "memory")
    ATT_DMA(0, 0);
    bf16x8 qr[NKS];
#pragma unroll
    for (int ks = 0; ks < NKS; ++ks) qr[ks] = *(const GAS bf16x8*)(Q + (size_t)(wave * 32 + r32) * qstride + ks * 16 + hi * 8);
    f32x16 o[NDB];
#pragma unroll
    for (int d = 0; d < NDB; ++d)
#pragma unroll
        for (int r = 0; r < 16; ++r) o[d][r] = 0.f;
    float m = -1e30f, l = 0.f;
    ATT_WAITBAR();
    for (int t = 0; t < NTmax; ++t) {
        const int sl = t & 1;
        if (t + 1 < NTmax) ATT_DMA(t + 1, sl ^ 1);
        if (t < NTw) {
            const LAS unsigned char* Kb = lds + KOFF + sl * KSLOT + hi * 1024 + r32 * 16;
            f32x16 p0, p1;
#pragma unroll
            for (int r = 0; r < 16; ++r) { p0[r] = 0.f; p1[r] = 0.f; }
#pragma unroll
            for (int ks = 0; ks < NKS; ++ks) {
                const bf16x8 a0 = *(const LAS bf16x8*)(Kb + ks * 2048), a1 = *(const LAS bf16x8*)(Kb + ks * 2048 + 512);
                p0 = ATT_MFMA(a0, qr[ks], p0); p1 = ATT_MFMA(a1, qr[ks], p1);
            }
            float mx = fmaxf(p0[0], p1[0]);
#pragma unroll
            for (int r = 1; r < 16; ++r) mx = fmaxf(mx, fmaxf(p0[r], p1[r]));
            mx = half_max(mx);
            if (__any(mx > m)) {
                const float mn = fmaxf(m, mx), alpha = __builtin_amdgcn_exp2f(m - mn);
                m = mn; l *= alpha;
                if (hi == 0) wsf[r32] = alpha;
                asm volatile("s_waitcnt lgkmcnt(0)" ::: "memory");
#pragma unroll
                for (int g = 0; g < 4; ++g) { const float a0 = wsf[8 * g + 4 * hi], a1 = wsf[8 * g + 4 * hi + 1], a2 = wsf[8 * g + 4 * hi + 2], a3 = wsf[8 * g + 4 * hi + 3];
#pragma unroll
                    for (int d = 0; d < NDB; ++d) { o[d][4 * g] *= a0; o[d][4 * g + 1] *= a1; o[d][4 * g + 2] *= a2; o[d][4 * g + 3] *= a3; } }
            }
            float ls = 0.f;
#pragma unroll
            for (int r = 0; r < 16; ++r) { p0[r] = __builtin_amdgcn_exp2f(p0[r] - m); p1[r] = __builtin_amdgcn_exp2f(p1[r] - m); ls += p0[r] + p1[r]; }
            l += ls;
            bf16x8 pa[4]; pa[0] = pack8(p0, 0); pa[1] = pack8(p0, 8); pa[2] = pack8(p1, 0); pa[3] = pack8(p1, 8);
            const LAS unsigned char* Vb = lds + VOFF + sl * VSLOT + (4 * hi + ((lane & 15) >> 2)) * 64 + ((lane >> 4) & 1) * 32 + (lane & 3) * 8;
#pragma unroll
            for (int d = 0; d < NDB; ++d)
#pragma unroll
                for (int ks = 0; ks < 4; ++ks) {
                    const s16x4 lo = __builtin_bit_cast(s16x4, __builtin_amdgcn_ds_read_tr16_b64_v4i16((LAS s16x4*)(Vb + d * 4096 + ks * 1024)));
                    const s16x4 hh = __builtin_bit_cast(s16x4, __builtin_amdgcn_ds_read_tr16_b64_v4i16((LAS s16x4*)(Vb + d * 4096 + ks * 1024 + 512)));
                    const bf16x8 vf = {lo[0], lo[1], lo[2], lo[3], hh[0], hh[1], hh[2], hh[3]};
                    o[d] = ATT_MFMA(pa[ks], vf, o[d]);
                }
        }
        ATT_WAITBAR();
    }
    l = half_sum(l);
    if (hi == 0) wsf[32 + r32] = 1.0f / l;
    asm volatile("s_waitcnt lgkmcnt(0)" ::: "memory");
    volatile LAS unsigned short* stg = (volatile LAS unsigned short*)(lds + OST + wave * 8192);
#pragma unroll
    for (int g = 0; g < 4; ++g)
#pragma unroll
        for (int e = 0; e < 4; ++e) { const int q = 8 * g + 4 * hi + e; const float il = wsf[32 + q];
#pragma unroll
            for (int d = 0; d < NDB; ++d) stg[q * DV + d * 32 + r32] = (unsigned short)f2bf(o[d][4 * g + e] * il); }
    asm volatile("s_waitcnt lgkmcnt(0)" ::: "memory");
#pragma unroll
    for (int i = 0; i < (32 * DV / 8) / 64; ++i) { const int c = i * 64 + lane, row = c / (DV / 8), ch = c % (DV / 8);
        const v4u v = *(const LAS v4u*)(lds + OST + wave * 8192 + (row * DV + ch * 8) * 2);
        *(GAS v4u*)(O + (size_t)(wave * 32 + row) * ostride + ch * 8) = v; }
    asm volatile("s_waitcnt lgkmcnt(0)" ::: "memory");
#undef ATT_DMA
#undef ATT_WAITBAR
}
}
__device__ __forceinline__ void p3_fast(const Frame& F, int only_kind = -1) {
    const bf16* QM = (const bf16*)(F.ws + WS_QM); const bf16* KM = (const bf16*)(F.ws + WS_KM); const bf16* VM = (const bf16*)(F.ws + WS_VM);
    const bf16* QD = (const bf16*)(F.ws + WS_DQ); const bf16* KD = (const bf16*)(F.ws + WS_KD); const bf16* DV = (const bf16*)(F.ws + WS_DV);
    bf16* OM = (bf16*)(F.ws + WS_OM); bf16* OD = (bf16*)(F.ws + WS_OD);
    for (int U = F.vcu; U < 1024; U += F.G) {
        const int j = U >> 8, v = U & 255, stream = v >> 3, s = v & 7, b = stream >> 3, hh = stream & 7;
        const int qb = (j & 1) ? 15 - s : s; const size_t tok0 = (size_t)b * SEQ + qb * 256;
        if (only_kind >= 0 && (j >> 1) != only_kind) continue;
        if (j < 2) att::attn_unit<96, 64>(F.lds, QM + (tok0 * 8 + hh) * 96, 768, KM + (size_t)(b * 8 + hh) * SEQ * 96, VM + (size_t)(b * 8 + hh) * SEQ * 64, 64, OM + tok0 * 512 + hh * 64, 512, qb);
        else att::attn_unit<64, 128>(F.lds, QD + (tok0 * 8 + hh) * 64, 512, KD + (size_t)(b * 8 + hh) * SEQ * 64, DV + (size_t)b * SEQ * 512 + (hh >> 1) * 128, 512, OD + (tok0 * 8 + hh) * 128, 1024, qb);
    }
}


struct MoeSched {
    const LAS int* tab;
    int G, c, ncol;
    const char* A; const char* Bt; size_t a_tstep, b_estep, b_tstep; const int* list;
    __device__ __forceinline__ bool next(int i, pg8::Unit& u) const {
        const int L = i * G + c, ti = L / ncol, ct = L - ti * ncol;
        int base = 0, e = 0;
        for (; e < NEXP; ++e) { const int nt = tab[e]; if (ti < base + nt) break; base += nt; }
        if (e >= NEXP) return false;
        u.pm = ti; u.pn = ct; u.aux = e | ((ti - base) << 8); return true;
    }
    __device__ __forceinline__ const char* a_tile(const pg8::Unit& u) const { return A + (size_t)u.pm * a_tstep; }
    __device__ __forceinline__ const char* b_tile(const pg8::Unit& u) const { return Bt + (size_t)(u.aux & 255) * b_estep + (size_t)u.pn * b_tstep; }
    __device__ __forceinline__ unsigned a_voff(const pg8::Unit& u, int row) const {
        const int e = u.aux & 255, idx = (u.aux >> 8) * 256 + row; const int n = tab[32 + e];
        const int ent = idx < n ? list[e * NTOK + idx] : 0; return (unsigned)(ent >> 1) * 2048u; }
};
struct GatherSched : MoeSched {
    __device__ __forceinline__ const char* a_tile(const pg8::Unit&) const { return A; }
};
struct EpiGU {
    static constexpr bool PERM = true;
    bf16* H;
    __device__ __forceinline__ void operator()(const pg8::f32x4 (&acc)[2][2][4][2], const pg8::Unit& u, int wr, int wc, int fr, int fq) const {
        const int row0 = u.pm * 256 + wr * 64 + fr, col0 = u.pn * 128 + wc * 32 + 8 * fq;
#pragma unroll
        for (int ai = 0; ai < 2; ++ai)
#pragma unroll
            for (int m = 0; m < 4; ++m) { float h[8];
#pragma unroll
                for (int n = 0; n < 2; ++n)
#pragma unroll
                    for (int e = 0; e < 4; ++e) { const float g = acc[ai][0][m][n][e], up = acc[ai][1][m][n][e];
                        h[4 * n + e] = g * __builtin_amdgcn_rcpf(1.0f + __builtin_amdgcn_exp2f(-LOG2E * g)) * up; }
                pg8::u32x4 w; w.x = pg8::cvt_pk_bf16(h[0], h[1]); w.y = pg8::cvt_pk_bf16(h[2], h[3]); w.z = pg8::cvt_pk_bf16(h[4], h[5]); w.w = pg8::cvt_pk_bf16(h[6], h[7]);
                *(pg8::u32x4*)(H + (size_t)(row0 + ai * 128 + m * 16) * 256 + col0) = w; }
    }
};
struct EpiDown {
    static constexpr bool PERM = true;
    const LAS int* tab; const int* list; const float* tokw; bf16* Y;
    __device__ __forceinline__ void operator()(const pg8::f32x4 (&acc)[2][2][4][2], const pg8::Unit& u, int wr, int wc, int fr, int fq) const {
        const int e = u.aux & 255, rt = u.aux >> 8, n = tab[32 + e]; const int col0 = u.pn * 256 + wc * 32 + 8 * fq;
#pragma unroll
        for (int ai = 0; ai < 2; ++ai)
#pragma unroll
            for (int m = 0; m < 4; ++m) { const int idx = rt * 256 + wr * 64 + fr + ai * 128 + m * 16;
                if (idx < n) { const int ent = list[e * NTOK + idx]; const float w = tokw[ent];
                    bf16* yr = Y + ((size_t)(ent & 1) * NTOK + (ent >> 1)) * 1024 + col0;
#pragma unroll
                    for (int bj = 0; bj < 2; ++bj) { const pg8::f32x4 v0 = acc[ai][bj][m][0] * w, v1 = acc[ai][bj][m][1] * w;
                        pg8::u32x4 o; o.x = pg8::cvt_pk_bf16(v0[0], v0[1]); o.y = pg8::cvt_pk_bf16(v0[2], v0[3]); o.z = pg8::cvt_pk_bf16(v1[0], v1[1]); o.w = pg8::cvt_pk_bf16(v1[2], v1[3]);
                        *(pg8::u32x4*)(yr + bj * 128) = o; } }
                asm volatile("" ::: "memory"); }
    }
};
__device__ __forceinline__ void moe_table(const Frame& F) {
    LAS int* tab = (LAS int*)(F.lds + MOE_TAB_OFF);
    if (F.tid < NEXP) { const int c = (int)__hip_atomic_load((unsigned*)(F.ctl + CW_CNT) + F.tid, __ATOMIC_RELAXED, __HIP_MEMORY_SCOPE_AGENT); tab[F.tid] = (c + 255) >> 8; tab[32 + F.tid] = c; }
    __syncthreads();
}
__device__ __forceinline__ void p7a_fast(const Frame& F) {
    moe_table(F);
    GatherSched S; S.tab = (const LAS int*)(F.lds + MOE_TAB_OFF); S.G = F.G; S.c = F.vcu; S.ncol = 2;
    S.A = (const char*)(F.ws + WS_XN); S.Bt = (const char*)(F.ws + WS_WGUT); S.a_tstep = 0; S.b_estep = (size_t)512 * 1024 * 2; S.b_tstep = (size_t)256 * 1024 * 2; S.list = (const int*)(F.ws + WS_LIST);
    EpiGU E{(bf16*)(F.ws + WS_HS)};
    pg8::gemm_phase<EpiGU, GatherSched, true, true, true>(F.lds, 1024, S, E);
}
__device__ __forceinline__ void p7b_fast(const Frame& F) {
    moe_table(F);
    MoeSched S; S.tab = (const LAS int*)(F.lds + MOE_TAB_OFF); S.G = F.G; S.c = F.vcu; S.ncol = 4;
    S.A = (const char*)(F.ws + WS_HS); S.Bt = (const char*)(F.ws + WS_WDT); S.a_tstep = (size_t)256 * 256 * 2; S.b_estep = (size_t)1024 * 256 * 2; S.b_tstep = (size_t)256 * 256 * 2; S.list = (const int*)(F.ws + WS_LIST);
    EpiDown E{(const LAS int*)(F.lds + MOE_TAB_OFF), (const int*)(F.ws + WS_LIST), (const float*)(F.ws + WS_TAB + TB_TOKW), (bf16*)(F.ws + WS_Y)};
    pg8::gemm_phase<EpiDown, MoeSched, true, true, false>(F.lds, 256, S, E);
}


namespace p2f {
using att::bf16x8; using att::f32x16; using att::half_sum; using att::pkbf;
__device__ __forceinline__ void store4(bf16* p, float a, float b, float c, float d) { v2u w; w.x = pkbf(a, b); w.y = pkbf(c, d); *(GAS v2u*)p = w; }
__device__ __forceinline__ float sq8(const bf16x8& v) { float s = 0.f;
#pragma unroll
    for (int j = 0; j < 8; ++j) { const float x = bf2f((unsigned short)v[j]); s += x * x; } return s; }
__device__ __forceinline__ float sq16(const f32x16& v) { float s = 0.f;
#pragma unroll
    for (int j = 0; j < 16; ++j) s += v[j] * v[j]; return s; }

__device__ __forceinline__ void q_task(const Frame& F, int blk) {
    const int lane = F.lane, r32 = lane & 31, hi = lane >> 5, tok = blk * 32 + r32, pos = tok & (SEQ - 1);
    const bf16* lat = (const bf16*)(F.ws + WS_LAT) + (size_t)tok * 512; const bf16* WT = (const bf16*)(F.ws + WS_WUQT);
    bf16* QM = (bf16*)(F.ws + WS_QM); const float* qg = F.in[I_QG];
    const float* cosm = (const float*)(F.ws + WS_TAB + TB_COSM) + pos * 16; const float* sinm = (const float*)(F.ws + WS_TAB + TB_SINM) + pos * 16;
    bf16x8 lb[16]; float ss = 0.f;
#pragma unroll
    for (int ks = 0; ks < 16; ++ks) { lb[ks] = *(const GAS bf16x8*)(lat + 16 * ks + 8 * hi); ss += sq8(lb[ks]); }
    const float rs = 1.0f / sqrtf(half_sum(ss) * (1.f / 256.f) + EPS);
    f32x4 cc[2], sn[2];
#pragma unroll
    for (int g = 0; g < 2; ++g) { cc[g] = *(const GAS f32x4*)(cosm + 8 * g + 4 * hi); sn[g] = *(const GAS f32x4*)(sinm + 8 * g + 4 * hi); }
#pragma unroll 1
    for (int h = 0; h < 8; ++h) {
        f32x16 acc[3];
#pragma unroll
        for (int nb = 0; nb < 3; ++nb) {
#pragma unroll
            for (int r = 0; r < 16; ++r) acc[nb][r] = 0.f;
            const bf16* wr = WT + (size_t)(h * 96 + 32 * nb + r32) * 256 + 8 * hi;
#pragma unroll
            for (int ks = 0; ks < 16; ++ks) { const bf16x8 a = *(const GAS bf16x8*)(wr + 16 * ks); acc[nb] = ATT_MFMA(a, lb[ks], acc[nb]); }
        }
        const float sq = half_sum(sq16(acc[0]) + sq16(acc[1]) + sq16(acc[2])) * rs * rs;
        const float sc = rs * (1.0f / sqrtf(sq * (1.f / 96.f) + EPS)) * QS_MLA;
        bf16* o = QM + ((size_t)tok * 8 + h) * 96 + 4 * hi;
#pragma unroll
        for (int nb = 0; nb < 2; ++nb)
#pragma unroll
            for (int g = 0; g < 4; ++g) { const f32x4 gn = *(const GAS f32x4*)(qg + 32 * nb + 8 * g + 4 * hi);
                store4(o + 32 * nb + 8 * g, acc[nb][4 * g] * sc * gn.x, acc[nb][4 * g + 1] * sc * gn.y, acc[nb][4 * g + 2] * sc * gn.z, acc[nb][4 * g + 3] * sc * gn.w); }
#pragma unroll
        for (int g = 0; g < 2; ++g) { const f32x4 ga = *(const GAS f32x4*)(qg + 64 + 8 * g + 4 * hi), gb = *(const GAS f32x4*)(qg + 80 + 8 * g + 4 * hi);
            float o1[4], o2[4];
#pragma unroll
            for (int e = 0; e < 4; ++e) { const float v1 = acc[2][4 * g + e] * sc * ga[e], v2 = acc[2][4 * g + 8 + e] * sc * gb[e];
                o1[e] = v1 * cc[g][e] - v2 * sn[g][e]; o2[e] = v2 * cc[g][e] + v1 * sn[g][e]; }
            store4(o + 64 + 8 * g, o1[0], o1[1], o1[2], o1[3]); store4(o + 80 + 8 * g, o2[0], o2[1], o2[2], o2[3]); }
    }
}
__device__ __forceinline__ void kv_task(const Frame& F, int blk) {
    const int lane = F.lane, r32 = lane & 31, hi = lane >> 5, tok = blk * 32 + r32, pos = tok & (SEQ - 1), b = tok >> 12;
    const bf16* lat = (const bf16*)(F.ws + WS_LAT) + (size_t)tok * 512 + 256; const bf16* WT = (const bf16*)(F.ws + WS_WUKVT);
    bf16* KM = (bf16*)(F.ws + WS_KM); bf16* VM = (bf16*)(F.ws + WS_VM); const float* kg = F.in[I_KG];
    const float* cosm = (const float*)(F.ws + WS_TAB + TB_COSM) + pos * 16; const float* sinm = (const float*)(F.ws + WS_TAB + TB_SINM) + pos * 16;
    bf16x8 lb[8]; float ss = 0.f;
#pragma unroll
    for (int ks = 0; ks < 8; ++ks) { lb[ks] = *(const GAS bf16x8*)(lat + 16 * ks + 8 * hi); ss += sq8(lb[ks]); }
    const float rs = 1.0f / sqrtf(half_sum(ss) * (1.f / 128.f) + EPS);
    float kr[16]; float skr = 0.f;
#pragma unroll
    for (int g = 0; g < 4; ++g) { const v2u w = *(const GAS v2u*)(lat + 128 + 8 * g + 4 * hi);
        kr[4 * g] = bf2f(w.x); kr[4 * g + 1] = bf2f(w.x >> 16); kr[4 * g + 2] = bf2f(w.y); kr[4 * g + 3] = bf2f(w.y >> 16); }
#pragma unroll
    for (int r = 0; r < 16; ++r) skr += kr[r] * kr[r];
    skr = half_sum(skr);
    f32x4 cc[2], sn[2];
#pragma unroll
    for (int g = 0; g < 2; ++g) { cc[g] = *(const GAS f32x4*)(cosm + 8 * g + 4 * hi); sn[g] = *(const GAS f32x4*)(sinm + 8 * g + 4 * hi); }
#pragma unroll 1
    for (int h = 0; h < 8; ++h) {
        f32x16 acc[4];
#pragma unroll
        for (int nb = 0; nb < 4; ++nb) {
#pragma unroll
            for (int r = 0; r < 16; ++r) acc[nb][r] = 0.f;
            const bf16* wr = WT + (size_t)(h * 128 + 32 * nb + r32) * 128 + 8 * hi;
#pragma unroll
            for (int ks = 0; ks < 8; ++ks) { const bf16x8 a = *(const GAS bf16x8*)(wr + 16 * ks); acc[nb] = ATT_MFMA(a, lb[ks], acc[nb]); }
        }
        const float sq = half_sum(sq16(acc[0]) + sq16(acc[1])) * rs * rs + skr;
        const float rn = 1.0f / sqrtf(sq * (1.f / 96.f) + EPS), sc = rs * rn;
        bf16* kb = KM + (((size_t)(b * 8 + h) * 64 + (pos >> 6)) * 12 * 64 + (pos & 63)) * 8 + 4 * hi;
#pragma unroll
        for (int nb = 0; nb < 2; ++nb)
#pragma unroll
            for (int g = 0; g < 4; ++g) { const f32x4 gn = *(const GAS f32x4*)(kg + 32 * nb + 8 * g + 4 * hi);
                store4(kb + (4 * nb + g) * 512, acc[nb][4 * g] * sc * gn.x, acc[nb][4 * g + 1] * sc * gn.y, acc[nb][4 * g + 2] * sc * gn.z, acc[nb][4 * g + 3] * sc * gn.w); }
#pragma unroll
        for (int g = 0; g < 2; ++g) { const f32x4 ga = *(const GAS f32x4*)(kg + 64 + 8 * g + 4 * hi), gb = *(const GAS f32x4*)(kg + 80 + 8 * g + 4 * hi);
            float o1[4], o2[4];
#pragma unroll
            for (int e = 0; e < 4; ++e) { const float v1 = kr[4 * g + e] * rn * ga[e], v2 = kr[4 * g + 8 + e] * rn * gb[e];
                o1[e] = v1 * cc[g][e] - v2 * sn[g][e]; o2[e] = v2 * cc[g][e] + v1 * sn[g][e]; }
            store4(kb + (8 + g) * 512, o1[0], o1[1], o1[2], o1[3]); store4(kb + (10 + g) * 512, o2[0], o2[1], o2[2], o2[3]); }
        bf16* vo = VM + ((size_t)(b * 8 + h) * SEQ + pos) * 64 + 4 * hi;
#pragma unroll
        for (int nb = 0; nb < 2; ++nb)
#pragma unroll
            for (int g = 0; g < 4; ++g) store4(vo + 32 * nb + 8 * g, acc[2 + nb][4 * g] * rs, acc[2 + nb][4 * g + 1] * rs, acc[2 + nb][4 * g + 2] * rs, acc[2 + nb][4 * g + 3] * rs);
    }
}
template <bool ISK>
__device__ __forceinline__ void dqk_task(const Frame& F, int blk) {
    const int lane = F.lane, r32 = lane & 31, hi = lane >> 5, tok = blk * 32 + r32, pos = tok & (SEQ - 1), b = tok >> 12;
    const float* gp = F.in[ISK ? I_DKG : I_DQG] + 32 * hi;
    const float* cosd = (const float*)(F.ws + WS_TAB + TB_COSD) + pos * 8; const float* sind = (const float*)(F.ws + WS_TAB + TB_SIND) + pos * 8;
    const f32x4 c0 = *(const GAS f32x4*)cosd, c1 = *(const GAS f32x4*)(cosd + 4), s0 = *(const GAS f32x4*)sind, s1 = *(const GAS f32x4*)(sind + 4);
    bf16* base = (bf16*)(F.ws + (ISK ? WS_DKR : WS_DQ)) + (size_t)tok * 512 + 32 * hi; bf16* KD = (bf16*)(F.ws + WS_KD);
    const float qs = ISK ? 1.0f : QS_DIFF;
#pragma unroll 1
    for (int hs = 0; hs < 8; ++hs) {
        float f[32]; float ss = 0.f;
#pragma unroll
        for (int c = 0; c < 4; ++c) { const v4u w = *(const GAS v4u*)(base + hs * 64 + 8 * c);
            f[8 * c] = bf2f(w.x); f[8 * c + 1] = bf2f(w.x >> 16); f[8 * c + 2] = bf2f(w.y); f[8 * c + 3] = bf2f(w.y >> 16);
            f[8 * c + 4] = bf2f(w.z); f[8 * c + 5] = bf2f(w.z >> 16); f[8 * c + 6] = bf2f(w.w); f[8 * c + 7] = bf2f(w.w >> 16); }
#pragma unroll
        for (int i = 0; i < 32; ++i) ss += f[i] * f[i];
        const float rn = 1.0f / sqrtf(half_sum(ss) * (1.f / 64.f) + EPS) * qs;
#pragma unroll
        for (int c = 0; c < 8; ++c) { const f32x4 gn = *(const GAS f32x4*)(gp + 4 * c);
            f[4 * c] *= rn * gn.x; f[4 * c + 1] *= rn * gn.y; f[4 * c + 2] *= rn * gn.z; f[4 * c + 3] *= rn * gn.w; }
#pragma unroll
        for (int i = 0; i < 8; ++i) { const float c = i < 4 ? c0[i & 3] : c1[i & 3], s = i < 4 ? s0[i & 3] : s1[i & 3];
            const float v1 = f[i], v2 = f[8 + i], o1 = v1 * c - v2 * s, o2 = v2 * c + v1 * s;
            f[i] = hi == 0 ? o1 : v1; f[8 + i] = hi == 0 ? o2 : v2; }
#pragma unroll
        for (int c = 0; c < 4; ++c) { v4u w; w.x = pkbf(f[8 * c], f[8 * c + 1]); w.y = pkbf(f[8 * c + 2], f[8 * c + 3]); w.z = pkbf(f[8 * c + 4], f[8 * c + 5]); w.w = pkbf(f[8 * c + 6], f[8 * c + 7]);
            if (ISK) *(GAS v4u*)(KD + ((((size_t)(b * 8 + hs) * 64 + (pos >> 6)) * 8 + 4 * hi + c) * 64 + (pos & 63)) * 8) = w;
            else *(GAS v4u*)(base + hs * 64 + 8 * c) = w; }
    }
}
}
__device__ __forceinline__ void p2_fast(const Frame& F) {
    for (int T = GW; T < 2048; T += NGW) { const int type = T & 3, blk = T >> 2;
        if (type == 0) p2f::q_task(F, blk); else if (type == 1) p2f::kv_task(F, blk); else if (type == 2) p2f::dqk_task<false>(F, blk); else p2f::dqk_task<true>(F, blk); }
}

constexpr int NPH = 11;
__global__ void __launch_bounds__(NWAVES * 64, 2) fwd_kernel(Args args) {
    extern __shared__ __attribute__((aligned(16))) unsigned char lds[];
    Frame F;
    F.lds = (LAS unsigned char*)lds;
    F.tid = threadIdx.x; F.lane = F.tid & 63; F.wave = __builtin_amdgcn_readfirstlane(F.tid >> 6);
    F.G = gridDim.x; { const int bx = blockIdx.x; F.vcu = (F.G % 8 == 0) ? (bx % 8) * (F.G / 8) + bx / 8 : bx; }
    F.in = args.in; F.out = args.out; F.ws = args.ws; F.ctl = (gu32*)(args.ws + WS_CTL);
    for (int u = F.tid; u < (LDS_BYTES - LDSCTL_OFF) / 4; u += NWAVES * 64) ((LAS unsigned*)(F.lds + LDSCTL_OFF))[u] = 0u;
    __syncthreads();
    const int lo = args.ph_lo, hi = args.ph_hi;
    const bool multi = (hi - lo) > 1;
    XcdBarrier bar; bar.bar = (unsigned*)(F.ctl + CW_BAR); bar.x = 0; bar.st = nullptr;
    if (multi) bar = xcd_barrier_post((unsigned*)(F.ctl + CW_BAR), (volatile LAS unsigned*)(F.lds + MISC_OFF) + 8);
#define IN(k) (lo <= (k) && (k) < hi)
#define SEAM(k) do { if (IN(k) && IN((k) + 1)) xcd_barrier(bar); } while (0)
    if (IN(0)) { p0_weights(F); p0_prologue(F); } SEAM(0);
    if (IN(1)) { p1_fast(F); } SEAM(1);
    if (IN(2)) { p2_fast(F); } SEAM(2);
    if (IN(3)) { p3_fast(F); } SEAM(3);
    if (IN(4)) { p3b_combine(F); } SEAM(4);
    if (IN(5)) { p4_fast(F); } SEAM(5);
    if (IN(6)) { p5_fast(F); } SEAM(6);
    if (IN(7)) { p6_router(F); p6_expert_weights(F); } SEAM(7);
    if (IN(8)) { p7a_fast(F); } SEAM(8);
    if (IN(9)) { p7b_fast(F); } SEAM(9);
    if (IN(10)) { p8_final(F); }
#undef IN
#undef SEAM
}

extern "C" void kernel_launch(void* const* d_in, const int* in_sizes, int n_in, void* d_out, int out_size, void* d_ws, size_t ws_size, hipStream_t stream) {
    static int grid = 0;
    if (grid == 0) {
        if (n_in != 27 || out_size != NTOK * DM || ws_size < WS_END) { fprintf(stderr, "kernel_launch: unexpected problem shape (n_in %d out %d ws %zu)\n", n_in, out_size, ws_size); grid = -1; return; }
        int dev = 0, cus = 0, per_cu = 0;
        if (hipGetDevice(&dev) != hipSuccess || hipDeviceGetAttribute(&cus, hipDeviceAttributeMultiprocessorCount, dev) != hipSuccess) { grid = -1; return; }
        if (hipFuncSetAttribute((const void*)fwd_kernel, hipFuncAttributeMaxDynamicSharedMemorySize, LDS_BYTES) != hipSuccess) { fprintf(stderr, "kernel_launch: hipFuncSetAttribute failed\n"); grid = -1; return; }
        if (hipOccupancyMaxActiveBlocksPerMultiprocessor(&per_cu, (const void*)fwd_kernel, NWAVES * 64, LDS_BYTES) != hipSuccess || per_cu < 1) { fprintf(stderr, "kernel_launch: occupancy query says %d\n", per_cu); per_cu = 1; }
        (void)hipGetLastError();
        grid = cus;
    }
    if (grid < 0) return;
    (void)hipMemsetAsync((char*)d_ws + WS_CTL, 0, CTL_ZERO_BYTES, stream);
    Args a{};
    for (int i = 0; i < 27; ++i) a.in[i] = (const float*)d_in[i];
    a.out = (float*)d_out; a.ws = (unsigned char*)d_ws;
#if MK_N_LAUNCHES == 1
    a.ph_lo = 0; a.ph_hi = NPH; a.li = 0;
    hipLaunchKernelGGL(fwd_kernel, dim3(grid), dim3(NWAVES * 64), LDS_BYTES, stream, a);
#else
    for (int p = 0; p < NPH; ++p) { a.ph_lo = p; a.ph_hi = p + 1; a.li = p;
        hipLaunchKernelGGL(fwd_kernel, dim3(grid), dim3(NWAVES * 64), LDS_BYTES, stream, a); }
#endif
}
```
